# Optimizing an MI355X kernel written in HIP

```python
import jax
import jax.numpy as jnp
from jax import lax
import numpy as np


D_MODEL = 1024
BATCH = 4
SEQ = 4096
DEPTH = 2

GRID_W = 64
CTX_LEN = 256
D_CONV = D_MODEL // 2
D_NA = D_MODEL - D_CONV
NA_HEADS = 8
HEAD_DIM = D_NA // NA_HEADS
CONV_WIDTH = 31
NA_KH = 8
NA_KW = 16
FNET_GROUPS = 4
D_FF = ((8 * D_MODEL // 3 + 255) // 256) * 256
N_MOD = 9
EPS = 1e-6

kernel_name = 'hybrid_conv_natten_fnet_dit_block'


def _rms(x, g):
    x32 = x.astype(jnp.float32)
    y = x32 * lax.rsqrt(jnp.mean(x32 * x32, axis=-1, keepdims=True) + EPS)
    return (y * g.astype(jnp.float32)).astype(x.dtype)


def _layernorm(x, g, b):
    x32 = x.astype(jnp.float32)
    mu = jnp.mean(x32, axis=-1, keepdims=True)
    var = jnp.mean(jnp.square(x32 - mu), axis=-1, keepdims=True)
    y = (x32 - mu) * lax.rsqrt(var + EPS)
    return (y * g.astype(jnp.float32) + b.astype(jnp.float32)).astype(x.dtype)


def _modulate(x, shift, scale):
    return x * (1 + scale) + shift


def _swiglu(x, w_in, w_out):
    gt, up = jnp.split(x @ w_in, 2, axis=-1)
    return (jax.nn.silu(gt) * up) @ w_out


def _ffn_sublayer(h, shift, scale, gate, g, w_in, w_out):
    return h + 0.5 * gate * _swiglu(_modulate(_rms(h, g), shift, scale), w_in, w_out)


def _conv_module(u, w, b, ln_g, ln_b):
    a, gt = jnp.split(u, 2, axis=-1)
    y = a * jax.nn.sigmoid(gt)
    y = lax.conv_general_dilated(
        y, w[:, None, :].astype(y.dtype), window_strides=(1,),
        padding=[(CONV_WIDTH // 2, CONV_WIDTH // 2)],
        dimension_numbers=('NWC', 'WIO', 'NWC'), feature_group_count=D_CONV) + b
    return jax.nn.silu(_layernorm(y, ln_g, ln_b))


def _split_heads(t):
    b, n, _ = t.shape
    return t.reshape(b, n, NA_HEADS, HEAD_DIM).transpose(0, 2, 1, 3)


def _neighbourhood_attention(q, k, v, kc, vc, rpb):
    b, h, L, dh = q.shape
    rows = L // GRID_W
    kh = min(NA_KH, rows)
    kw = NA_KW
    scale = dh ** -0.5
    qg = q.reshape(b, h, rows, GRID_W, dh)
    kg = k.reshape(b, h, rows, GRID_W, dh)
    vg = v.reshape(b, h, rows, GRID_W, dh)
    row_start = jnp.clip(jnp.arange(rows) - kh // 2, 0, rows - kh)
    col_start = jnp.clip(jnp.arange(GRID_W) - kw // 2, 0, GRID_W - kw)
    col_idx = col_start[:, None] + jnp.arange(kw)[None, :]
    col_off = col_idx - jnp.arange(GRID_W)[:, None]
    bias_col = rpb[:, :, col_off + NA_KW - 1]

    def row_block(args):
        q_r, r, rs = args
        k_r = lax.dynamic_slice_in_dim(kg, rs, kh, axis=2)
        v_r = lax.dynamic_slice_in_dim(vg, rs, kh, axis=2)
        k_win = k_r[:, :, :, col_idx]
        v_win = v_r[:, :, :, col_idx]
        s_loc = jnp.einsum('bhwd,bhawkd->bhwak', q_r, k_win)
        row_off = rs + jnp.arange(kh) - r
        bias = jnp.transpose(bias_col[:, row_off + NA_KH - 1], (0, 2, 1, 3))
        s_loc = (s_loc * scale + bias).reshape(b, h, GRID_W, kh * kw)
        s_ctx = jnp.einsum('bhwd,bhnd->bhwn', q_r, kc) * scale
        p = jax.nn.softmax(jnp.concatenate([s_loc, s_ctx], axis=-1).astype(jnp.float32), axis=-1).astype(q.dtype)
        p_loc = p[..., :kh * kw].reshape(b, h, GRID_W, kh, kw)
        p_ctx = p[..., kh * kw:]
        return (jnp.einsum('bhwak,bhawkd->bhwd', p_loc, v_win)
                + jnp.einsum('bhwn,bhnd->bhwd', p_ctx, vc))

    out = lax.map(row_block, (jnp.moveaxis(qg, 2, 0), jnp.arange(rows), row_start))
    return out.transpose(1, 0, 3, 2, 4).reshape(b, L, h * dh)


def _context_attention(qc, kc, vc):
    b, h, n, dh = qc.shape
    s = jnp.einsum('bhnd,bhmd->bhnm', qc, kc) * (dh ** -0.5)
    p = jax.nn.softmax(s.astype(jnp.float32), axis=-1).astype(qc.dtype)
    o = jnp.einsum('bhnm,bhmd->bhnd', p, vc)
    return o.transpose(0, 2, 1, 3).reshape(b, n, h * dh)


def _ab_mixer(hn, hcn, w_in, conv_w, conv_b, ln_g, ln_b, rpb, w_out):
    p = hn @ w_in
    pc = hcn @ w_in
    o1, o2, o3 = 2 * D_CONV, 2 * D_CONV + D_NA, 2 * D_CONV + 2 * D_NA
    conv_x = _conv_module(p[..., :o1], conv_w, conv_b, ln_g, ln_b)
    conv_c = _conv_module(pc[..., :o1], conv_w, conv_b, ln_g, ln_b)
    q, k, v = _split_heads(p[..., o1:o2]), _split_heads(p[..., o2:o3]), _split_heads(p[..., o3:])
    qc, kc, vc = _split_heads(pc[..., o1:o2]), _split_heads(pc[..., o2:o3]), _split_heads(pc[..., o3:])
    att_x = _neighbourhood_attention(q, k, v, kc, vc, rpb)
    att_c = _context_attention(qc, kc, vc)
    y = jnp.concatenate([conv_x, att_x], axis=-1) @ w_out
    yc = jnp.concatenate([conv_c, att_c], axis=-1) @ w_out
    return y, yc


def _fourier_mixer(hn, w, b):
    bsz, L, d = hn.shape
    g = hn.astype(jnp.float32).reshape(bsz, L, FNET_GROUPS, d // FNET_GROUPS)
    f = jnp.fft.fft2(g, axes=(1, 3), norm='ortho').real.astype(hn.dtype).reshape(bsz, L, d)
    return f @ w + b


def setup_inputs(seed: int = 0) -> dict:
    key = jax.random.key(seed)
    ks = jax.random.split(key, 20)
    n_even = (DEPTH + 1) // 2
    n_odd = DEPTH // 2
    nrm = jax.random.normal
    f32 = jnp.float32
    return {
        'x': nrm(ks[0], (BATCH, SEQ, D_MODEL), f32),
        'c': nrm(ks[1], (BATCH, D_MODEL), f32),
        'ctx': nrm(ks[2], (BATCH, CTX_LEN, D_MODEL), f32),
        'c_ctx': nrm(ks[3], (D_MODEL,), f32),
        'ada_w': 0.02 * nrm(ks[4], (DEPTH, D_MODEL, N_MOD * D_MODEL), f32),
        'ada_b': 0.01 * nrm(ks[5], (DEPTH, N_MOD * D_MODEL), f32),
        'norm_g': 1.0 + 0.01 * nrm(ks[6], (DEPTH, 3, D_MODEL), f32),
        'ffn_w_in': nrm(ks[7], (DEPTH, 2, D_MODEL, 2 * D_FF), f32) * D_MODEL ** -0.5,
        'ffn_w_out': nrm(ks[8], (DEPTH, 2, D_FF, D_MODEL), f32) * D_FF ** -0.5,
        'ab_w_in': nrm(ks[9], (n_even, D_MODEL, 2 * D_CONV + 3 * D_NA), f32) * D_MODEL ** -0.5,
        'conv_w': nrm(ks[10], (n_even, CONV_WIDTH, D_CONV), f32) * CONV_WIDTH ** -0.5,
        'conv_b': 0.01 * nrm(ks[11], (n_even, D_CONV), f32),
        'conv_ln_g': 1.0 + 0.01 * nrm(ks[12], (n_even, D_CONV), f32),
        'conv_ln_b': 0.01 * nrm(ks[13], (n_even, D_CONV), f32),
        'na_rpb': 0.1 * nrm(ks[14], (n_even, NA_HEADS, 2 * NA_KH - 1, 2 * NA_KW - 1), f32),
        'ab_w_out': nrm(ks[15], (n_even, D_CONV + D_NA, D_MODEL), f32) * (D_CONV + D_NA) ** -0.5,
        'fnet_w': nrm(ks[16], (n_odd, D_MODEL, D_MODEL), f32) * D_MODEL ** -0.5,
        'fnet_b': 0.01 * nrm(ks[17], (n_odd, D_MODEL), f32),
        'final_g': 1.0 + 0.01 * nrm(ks[18], (D_MODEL,), f32),
    }


def reference(x, c, ctx, c_ctx, ada_w, ada_b, norm_g, ffn_w_in, ffn_w_out, ab_w_in, conv_w, conv_b,
              conv_ln_g, conv_ln_b, na_rpb, ab_w_out, fnet_w, fnet_b, final_g):
    s_c = jax.nn.silu(c)
    s_cc = jax.nn.silu(c_ctx)
    h, hc = x, ctx
    for i in range(DEPTH):
        mod = (s_c @ ada_w[i] + ada_b[i]).reshape(c.shape[0], N_MOD, D_MODEL)[:, :, None, :]
        modc = (s_cc @ ada_w[i] + ada_b[i]).reshape(N_MOD, D_MODEL)
        m = [mod[:, k] for k in range(N_MOD)]
        mc = [modc[k] for k in range(N_MOD)]
        ctx_out = i < DEPTH - 1
        ctx_used = ctx_out or (i % 2 == 0)
        j = i // 2
        h = _ffn_sublayer(h, m[0], m[1], m[2], norm_g[i, 0], ffn_w_in[i, 0], ffn_w_out[i, 0])
        if ctx_used:
            hc = _ffn_sublayer(hc, mc[0], mc[1], mc[2], norm_g[i, 0], ffn_w_in[i, 0], ffn_w_out[i, 0])
        hn = _modulate(_rms(h, norm_g[i, 1]), m[3], m[4])
        if i % 2 == 0:
            hcn = _modulate(_rms(hc, norm_g[i, 1]), mc[3], mc[4])
            y, yc = _ab_mixer(hn, hcn, ab_w_in[j], conv_w[j], conv_b[j], conv_ln_g[j], conv_ln_b[j],
                              na_rpb[j], ab_w_out[j])
            h = h + m[5] * y
            if ctx_out:
                hc = hc + mc[5] * yc
        else:
            h = h + m[5] * _fourier_mixer(hn, fnet_w[j], fnet_b[j])
            if ctx_out:
                hcn = _modulate(_rms(hc, norm_g[i, 1]), mc[3], mc[4])
                hc = hc + mc[5] * _fourier_mixer(hcn, fnet_w[j], fnet_b[j])
        h = _ffn_sublayer(h, m[6], m[7], m[8], norm_g[i, 2], ffn_w_in[i, 1], ffn_w_out[i, 1])
        if ctx_out:
            hc = _ffn_sublayer(hc, mc[6], mc[7], mc[8], norm_g[i, 2], ffn_w_in[i, 1], ffn_w_out[i, 1])
    return _rms(h, final_g)
```

```cpp
#include <hip/hip_runtime.h>
#include <hip/hip_cooperative_groups.h>
#include <cstdio>
#include <cstdint>
namespace cg = cooperative_groups;

#define LAS __attribute__((address_space(3)))
typedef unsigned short bf16_t;
typedef short bf16x8 __attribute__((ext_vector_type(8)));
typedef float f32x4 __attribute__((ext_vector_type(4)));
typedef unsigned u32x4 __attribute__((ext_vector_type(4)));
typedef unsigned u32x2 __attribute__((ext_vector_type(2)));

constexpr int D = 1024, SEQ = 4096, NTOK = 16384, NCTX = 1024, MT = NTOK + NCTX, DFF = 2816, NFF1 = 2 * DFF, NAB = 2560;
constexpr int LDS_BYTES = 147456;

constexpr size_t WS_MOD = 0;
constexpr size_t WS_NG = 360u << 10;
constexpr size_t WS_BAR = 384u << 10;
constexpr int    CNT_WORD = 3584;
constexpr size_t WS_SS = 400u << 10;
constexpr size_t WS_SSF = 816u << 10;
constexpr size_t WS_CNTF = 880u << 10;
constexpr size_t WS_CNTX = 896u << 10;
constexpr size_t WS_CB = 1u << 20;
constexpr size_t WS_CBAB = WS_CB + (size_t)4 * 5 * 5632 * 4;
constexpr size_t WS_CBD = WS_CBAB + (size_t)5 * 2560 * 4;
static_assert(WS_SS + (size_t)6 * 17408 * 4 <= WS_CB && WS_CBD + 5 * 2048 * 4 <= (2u << 20), "small tables fit");
constexpr size_t WS_W1T = 2u << 20;
constexpr size_t SZ_W1T = (size_t)NFF1 * D * 2;
constexpr size_t WS_W2T = WS_W1T + 4 * SZ_W1T;
constexpr size_t SZ_W2T = (size_t)D * DFF * 2;
constexpr size_t WS_WABT = WS_W2T + 4 * SZ_W2T;
constexpr size_t WS_WOT = WS_WABT + (size_t)NAB * D * 2;
constexpr size_t WS_WFT = WS_WOT + (size_t)D * D * 2;
constexpr size_t WS_DFTC = WS_WFT + (size_t)D * D * 2;
constexpr size_t WS_DFTL = WS_DFTC + 512 * 256 * 2;
constexpr size_t WS_H = WS_DFTL + (size_t)4096 * 8192 * 2;
constexpr size_t WS_HC = WS_H + (size_t)NTOK * D * 2;
constexpr size_t WS_XN = WS_HC + (size_t)NCTX * D * 4;
constexpr size_t WS_ACT = WS_XN + (size_t)MT * D * 2;
constexpr size_t WS_END = WS_ACT + (size_t)MT * DFF * 2;
constexpr size_t WS_YG = WS_ACT;
constexpr size_t WS_QB = WS_YG + (size_t)NTOK * 512 * 2;
constexpr size_t WS_KB = WS_QB + (size_t)NTOK * 512 * 2;
constexpr size_t WS_VTL = WS_KB + (size_t)MT * 512 * 2;
constexpr size_t WS_VTC = WS_VTL + (size_t)NTOK * 512 * 2;
static_assert(WS_VTC + (size_t)NCTX * 512 * 2 <= WS_END, "mixer aliases fit");
constexpr size_t WS_MIX = WS_VTC + (size_t)NCTX * 512 * 2;
constexpr size_t WS_T = WS_ACT;
constexpr size_t WS_F = WS_T + (size_t)16 * 256 * 8192 * 2;
constexpr size_t WS_TOTAL = (WS_MIX + (size_t)NTOK * D * 2) > (WS_F + (size_t)NTOK * D * 2) ? (WS_MIX + (size_t)NTOK * D * 2) : (WS_F + (size_t)NTOK * D * 2);

__device__ __forceinline__ float wave_sum(float v) {
#pragma unroll
    for (int o = 1; o < 64; o <<= 1) v += __shfl_xor(v, o);
    return v;
}
__device__ __forceinline__ unsigned cvt_pk_bf16(float lo, float hi) { unsigned r; asm volatile("v_cvt_pk_bf16_f32 %0, %1, %2" : "=v"(r) : "v"(lo), "v"(hi)); return r; }
#define NT16(p, v) __builtin_nontemporal_store((v), (u32x4*)(p))
#define PL16(p, v) (*(u32x4*)(p) = (v))
#define PL8(p, v) (*(u32x2*)(p) = (v))
#define PL2(p, v) (*(bf16_t*)(p) = (bf16_t)(v))
#ifndef NTG
#define NTG 1
#endif
#define ST16(grp, p, v) do { if ((NTG >> (grp)) & 1) NT16(p, v); else PL16(p, v); } while (0)
__device__ __forceinline__ float bf2f(unsigned short b) { return __uint_as_float(((unsigned)b) << 16); }
__device__ __forceinline__ float fast_exp(float x) { return __builtin_amdgcn_exp2f(x * 1.44269504089f); }
__device__ __forceinline__ float sigmoidf_(float x) { return __builtin_amdgcn_rcpf(1.0f + fast_exp(-x)); }
__device__ __forceinline__ float siluf_(float x) { return x * sigmoidf_(x); }


#define XB_TMO      128
#define XB_XCNT(j)  (256  + 64 * (j))
#define XB_XSUB(j)  (1280 + 64 * (j))
#define XB_XGEN(j)  (2304 + 64 * (j))
#define XB_TOP      3328
#define XB_TOPGEN   3392
#define XCD_BAR_WORDS 3456
#define XB_SPIN_CAP (1u << 18)
__device__ __forceinline__ unsigned xb_ld(unsigned* p)              { return __hip_atomic_load(p, __ATOMIC_RELAXED, __HIP_MEMORY_SCOPE_AGENT); }
__device__ __forceinline__ unsigned xb_add(unsigned* p, unsigned v) { return __hip_atomic_fetch_add(p, v, __ATOMIC_RELAXED, __HIP_MEMORY_SCOPE_AGENT); }
__device__ __forceinline__ unsigned xb_xcc_id() { return (unsigned)__builtin_amdgcn_s_getreg((3 << 11) | 20) & 0xFu; }
#ifndef XB_SLEEP
#define XB_SLEEP 1
#endif
#define XB_SPIN(cond, bar) do { unsigned _sp = 0; while (cond) { if (XB_SLEEP) __builtin_amdgcn_s_sleep(1); \
    if ((++_sp & 255u) == 0u) { if (xb_ld(&(bar)[XB_TMO])) break; if (_sp > XB_SPIN_CAP) { atomicAdd(&(bar)[XB_TMO], 1u); break; } } } } while (0)
struct XcdBarrier { unsigned* bar; unsigned x; volatile LAS unsigned* st; };
__device__ __forceinline__ XcdBarrier xcd_barrier_post(unsigned* bar, volatile LAS unsigned* st) {
    XcdBarrier b; b.bar = bar; b.x = xb_xcc_id(); b.st = st;
    if (threadIdx.x == 0) (void)xb_add(&bar[XB_XCNT(b.x)], 1u);
    return b;
}
__device__ __forceinline__ void xcd_barrier_complete(unsigned* bar, unsigned x, unsigned& nloc, unsigned& nx) {
    const unsigned G = gridDim.x * gridDim.y * gridDim.z;
    unsigned sum, cnt, mine, sp = 0u;
    for (;;) {
        sum = 0u; cnt = 0u; mine = 0u;
#pragma unroll
        for (unsigned j = 0; j < 16; ++j) { const unsigned c = xb_ld(&bar[XB_XCNT(j)]); sum += c; cnt += (c > 0u) ? 1u : 0u; mine = (j == x) ? c : mine; }
        if (sum == G) break;
        __builtin_amdgcn_s_sleep(1);
        if ((++sp & 255u) == 0u) { if (xb_ld(&bar[XB_TMO])) break; if (sp > XB_SPIN_CAP) { atomicAdd(&bar[XB_TMO], 1u); break; } }
    }
    nloc = mine > 0u ? mine : 1u; nx = cnt > 0u ? cnt : 1u;
}
__device__ __forceinline__ void xcd_barrier(const XcdBarrier& b) {
    asm volatile("s_waitcnt vmcnt(0)" ::: "memory");
    __syncthreads();
    if (threadIdx.x == 0) {
        unsigned* bar = b.bar;
        __builtin_amdgcn_s_waitcnt(0);
        unsigned nloc = b.st[0], nx = b.st[1];
        if (nloc == 0u) { xcd_barrier_complete(bar, b.x, nloc, nx); b.st[0] = nloc; b.st[1] = nx; }
        const unsigned old = xb_add(&bar[XB_XSUB(b.x)], 1u);
        const unsigned gen = old / nloc;
        if (old + 1u == (gen + 1u) * nloc) {
            __builtin_amdgcn_fence(__ATOMIC_RELEASE, "agent");
            asm volatile("s_waitcnt vmcnt(0)" ::: "memory");
            const unsigned og = xb_add(&bar[XB_TOP], 1u);
            const unsigned tg = og / nx;
            if (og + 1u == (tg + 1u) * nx) xb_add(&bar[XB_TOPGEN], 1u);
            else XB_SPIN(xb_ld(&bar[XB_TOPGEN]) == tg, bar);
            __builtin_amdgcn_fence(__ATOMIC_ACQUIRE, "agent");
            xb_add(&bar[XB_XGEN(b.x)], 1u);
            asm volatile("s_waitcnt vmcnt(0)" ::: "memory");
        } else {
            XB_SPIN(xb_ld(&bar[XB_XGEN(b.x)]) == gen, bar);
            __builtin_amdgcn_fence(__ATOMIC_ACQUIRE, "agent");
            asm volatile("s_waitcnt vmcnt(0)" ::: "memory");
        }
    }
    __syncthreads();
}

namespace pg8 {
constexpr int BM = 256, BK = 64, HALF = 128, HTB = HALF * BK * 2, STAGE_BYTES = 8 * HTB, NXCD = 8, WGM = 8;
__host__ __device__ __forceinline__ int lds_byte(int r, int c) { const int st = (r >> 4) * 2 + (c >> 5), rr = r & 15, cc = c & 31, ob = rr * 64 + cc * 2; return st * 1024 + (ob ^ (((ob >> 9) & 1) << 5)); }
__host__ __device__ __forceinline__ void stage_rc(int b, int& R, int& C) { const int st = b / 1024, sb = b % 1024, swz = sb ^ (((sb >> 9) & 1) << 5); R = (st >> 1) * 16 + swz / 64; C = (st & 1) * 32 + (swz % 64) / 2; }
__host__ __device__ __forceinline__ int perm32(int rho) { const int n = rho >> 4, i = rho & 15; return 8 * (i >> 2) + 4 * n + (i & 3); }

struct Unit { const char* A; const char* B; int pm, pn, z; };
struct Gemm { int lda, ldb, K; };

__device__ __forceinline__ void static_map(int L, int nM, int nN, int& pm, int& pn) {
    const int nwg = nM * nN; int wgid = L;
    { const int q = nwg / NXCD, r = nwg % NXCD, xcd = wgid % NXCD, off = wgid / NXCD; wgid = (xcd < r ? xcd * (q + 1) : r * (q + 1) + (xcd - r) * q) + off; }
    const int nig = WGM * nN, gid = wgid / nig, fm = gid * WGM, gsz = (nM - fm) < WGM ? (nM - fm) : WGM;
    pm = fm + ((wgid % nig) % gsz); pn = (wgid % nig) / gsz;
}

template <class Epi, class Sched>
__device__ __forceinline__ void gemm_phase(LAS unsigned char* lds, const Gemm g, const Sched& S, const Epi& E) {
#ifndef PG8_ALIGN
#define PG8_ALIGN true
#endif
    constexpr bool ALIGN_EPI = PG8_ALIGN;
    int tid = threadIdx.x; asm volatile("" : "+v"(tid));
    const int wid = __builtin_amdgcn_readfirstlane(tid >> 6), lane = tid & 63, wr = wid >> 2, wc = wid & 3, fr = lane & 15, fq = lane >> 4;
    int K = g.K; asm volatile("" : "+s"(K));
    const int nt = K / BK;
    unsigned voffA[2], voffB[2];
#pragma unroll
    for (int i = 0; i < 2; ++i) { int R, C; stage_rc(tid * 16 + i * 8192, R, C); const int Rb = Epi::PERM ? ((R & ~31) + perm32(R & 31)) : R;
        voffA[i] = (unsigned)(R * g.lda + C) * 2u; voffB[i] = (unsigned)(Rb * g.ldb + C) * 2u; }
    const size_t kstep = (size_t)(BK * 2);
    const size_t hstepA = (size_t)HALF * g.lda * 2, hstepB = (size_t)HALF * g.ldb * 2;
    const unsigned ldsw = (unsigned)wid * 1024u;
    const int aoff = lds_byte(wr * 64 + fr, fq * 8), boff = lds_byte(wc * 32 + fr, fq * 8);
#define PG8_SA(b, h) (((b) * 2 + (h)) * HTB)
#define PG8_SB(b, h) ((4 + (b) * 2 + (h)) * HTB)
#define PG8_STAGE(bufoff, gbase, voff) do { _Pragma("unroll") for (int _i = 0; _i < 2; ++_i) \
        __builtin_amdgcn_global_load_lds((const unsigned*)((const char*)(gbase) + (voff)[_i]), (LAS unsigned*)(lds + (bufoff) + ldsw + _i * 8192), 16, 0, 0); } while (0)
#define PG8_LDA(dst, b, h) do { _Pragma("unroll") for (int m = 0; m < 4; ++m) _Pragma("unroll") for (int k = 0; k < 2; ++k) dst[m][k] = *(const LAS bf16x8*)(lds + PG8_SA(b, h) + aoff + m * 2048 + k * 1024); } while (0)
#define PG8_LDB(dst, b, h) do { _Pragma("unroll") for (int n = 0; n < 2; ++n) _Pragma("unroll") for (int k = 0; k < 2; ++k) dst[n][k] = *(const LAS bf16x8*)(lds + PG8_SB(b, h) + boff + n * 2048 + k * 1024); } while (0)
#define PG8_MMA(ai, bj, At, Bt) do { __builtin_amdgcn_s_setprio(1); _Pragma("unroll") for (int m = 0; m < 4; ++m) _Pragma("unroll") for (int n = 0; n < 2; ++n) _Pragma("unroll") for (int k = 0; k < 2; ++k) \
        acc[ai][bj][m][n] = __builtin_amdgcn_mfma_f32_16x16x32_bf16(Bt[n][k], At[m][k], acc[ai][bj][m][n], 0, 0, 0); __builtin_amdgcn_s_setprio(0); } while (0)
#define PG8_WAIT_V(n) asm volatile("s_waitcnt vmcnt(" #n ")" ::: "memory")
#define PG8_WAIT_L(n) asm volatile("s_waitcnt lgkmcnt(" #n ")" ::: "memory")
#define PG8_BAR __builtin_amdgcn_s_barrier()
#define PG8_SCHED __builtin_amdgcn_sched_barrier(0)
    Unit cur, nxt; int ui = 0;
    if (!S.next(0, cur)) return;
    f32x4 acc[2][2][4][2];
#pragma unroll
    for (int a = 0; a < 2; ++a)
#pragma unroll
        for (int b = 0; b < 2; ++b)
#pragma unroll
            for (int m = 0; m < 4; ++m)
#pragma unroll
                for (int n = 0; n < 2; ++n) acc[a][b][m][n] = (f32x4){0.f, 0.f, 0.f, 0.f};
    bf16x8 At[4][2], B0[2][2], B1[2][2];
    const char* cA = cur.A; const char* cB = cur.B;
    PG8_STAGE(PG8_SB(0, 0), cB, voffB); PG8_STAGE(PG8_SB(0, 1), cB + hstepB, voffB); PG8_STAGE(PG8_SA(0, 0), cA, voffA); PG8_STAGE(PG8_SA(0, 1), cA + hstepA, voffA);
    if (wr == 1) PG8_BAR;
    PG8_WAIT_V(2); PG8_BAR;
    PG8_STAGE(PG8_SB(1, 0), cB + kstep, voffB); PG8_STAGE(PG8_SA(1, 0), cA + kstep, voffA); PG8_STAGE(PG8_SB(1, 1), cB + hstepB + kstep, voffB);
    PG8_WAIT_V(6); PG8_BAR;
    for (;;) {
        const bool has_next = S.next(ui + 1, nxt);
        const char* nA = has_next ? nxt.A : cA; const char* nB = has_next ? nxt.B : cB;
        for (int t = 0; t < nt; t += 2) {
            const bool last = (t == nt - 2);
            const char* a1 = cA + (size_t)(t + 1) * kstep;
            const char* a2 = last ? nA : cA + (size_t)(t + 2) * kstep; const char* b2 = last ? nB : cB + (size_t)(t + 2) * kstep;
            const char* a3 = a2 + kstep; const char* b3 = b2 + kstep;
            PG8_LDB(B0, 0, 0); PG8_LDB(B1, 0, 1); PG8_SCHED; PG8_LDA(At, 0, 0); PG8_STAGE(PG8_SA(1, 1), a1 + hstepA, voffA);
            PG8_WAIT_V(8); PG8_WAIT_L(0); PG8_BAR; PG8_MMA(0, 0, At, B0); PG8_MMA(0, 1, At, B1); PG8_BAR; PG8_SCHED;
            PG8_LDA(At, 0, 1); PG8_STAGE(PG8_SB(0, 0), b2, voffB); PG8_STAGE(PG8_SB(0, 1), b2 + hstepB, voffB); PG8_STAGE(PG8_SA(0, 0), a2, voffA);
            PG8_WAIT_V(8); PG8_WAIT_L(0); PG8_BAR; PG8_MMA(1, 0, At, B0); PG8_MMA(1, 1, At, B1); PG8_BAR; PG8_SCHED;
            PG8_LDB(B0, 1, 0); PG8_LDB(B1, 1, 1); PG8_SCHED; PG8_LDA(At, 1, 0); PG8_STAGE(PG8_SA(0, 1), a2 + hstepA, voffA);
            PG8_WAIT_V(8); PG8_WAIT_L(0); PG8_BAR; PG8_MMA(0, 0, At, B0); PG8_MMA(0, 1, At, B1); PG8_BAR; PG8_SCHED;
            PG8_LDA(At, 1, 1); PG8_STAGE(PG8_SB(1, 0), b3, voffB); PG8_STAGE(PG8_SB(1, 1), b3 + hstepB, voffB); PG8_STAGE(PG8_SA(1, 0), a3, voffA);
            PG8_WAIT_V(8); PG8_WAIT_L(0); PG8_BAR; PG8_MMA(1, 0, At, B0); PG8_MMA(1, 1, At, B1); PG8_BAR; PG8_SCHED;
        }
        if constexpr (ALIGN_EPI) { if (wr == 0) PG8_BAR; }
        if constexpr (!Epi::AFTER_DRAIN) E(acc, cur, wr, wc, fr, fq);
        if (!has_next) break;
#pragma unroll
        for (int a = 0; a < 2; ++a)
#pragma unroll
            for (int b = 0; b < 2; ++b)
#pragma unroll
                for (int m = 0; m < 4; ++m)
#pragma unroll
                    for (int n = 0; n < 2; ++n) acc[a][b][m][n] = (f32x4){0.f, 0.f, 0.f, 0.f};
        cur = nxt; cA = nA; cB = nB; ++ui;
        if constexpr (ALIGN_EPI) { if (wr == 1) PG8_BAR; }
    }
    PG8_WAIT_V(0);
    if constexpr (!ALIGN_EPI) { if (wr == 0) PG8_BAR; }
    PG8_BAR;
    if constexpr (Epi::AFTER_DRAIN) E.fused(acc, cur, wr, wc, fr, fq);
#undef PG8_SA
#undef PG8_SB
#undef PG8_STAGE
#undef PG8_LDA
#undef PG8_LDB
#undef PG8_MMA
#undef PG8_WAIT_V
#undef PG8_WAIT_L
#undef PG8_BAR
#undef PG8_SCHED
}
}
using pg8::Unit;

struct PlainOrder {
    const char* A; const char* B; size_t tA, tB; int nM, nN, G, c;
    __device__ __forceinline__ bool next(int i, Unit& u) const {
        const int L = i * G + c; if (L >= nM * nN) return false;
        int pm, pn; pg8::static_map(L, nM, nN, pm, pn);
        u.pm = pm; u.pn = pn; u.z = 0; u.A = A + (size_t)pm * tA; u.B = B + (size_t)pn * tB; return true;
    }
};
struct MixInOrder {
    const char* A; const char* B; int G, c, lo, hi;
    __device__ __forceinline__ bool next(int i, Unit& u) const {
        const int L = lo + i * G + c; if (L >= hi) return false;
        int pm, pn;
        if (L < 640) pg8::static_map(L, 64, 10, pm, pn); else { const int e = L - 640; pm = 64 + (e >> 2); pn = 6 + (e & 3); }
        u.pm = pm; u.pn = pn; u.z = 0; u.A = A + (size_t)pm * (256 * D * 2); u.B = B + (size_t)pn * (256 * D * 2); return true;
    }
};
struct CtxSplitOrder {
    const char* A; const char* B; int G, c;
    __device__ __forceinline__ bool next(int i, Unit& u) const {
        const int L = i * G + c; if (L >= 176) return false;
        const int t = L / 11, sp = L - t * 11, pm = t >> 2, pn = t & 3;
        u.pm = pm; u.pn = pn; u.z = sp; u.A = A + ((size_t)(NTOK + pm * 256) * DFF + sp * 256) * 2; u.B = B + ((size_t)(pn * 256) * DFF + sp * 256) * 2; return true;
    }
};
struct DftAOrder {
    const char* A; const char* XN; int G, v;
    __device__ __forceinline__ bool next(int i, Unit& u) const {
        const int L = i * G + v; if (L >= 512) return false;
        const int bg = L >> 5, rem = L & 31, pm = rem >> 4, pn = rem & 15, b = bg >> 2, gr = bg & 3;
        u.pm = pm; u.pn = pn; u.z = bg; u.A = A + (size_t)pm * (256 * 256 * 2); u.B = XN + ((size_t)(b * SEQ + pn * 256) * D + gr * 256) * 2; return true;
    }
};
struct DftBOrder {
    const char* A; const char* T; int G, v;
    __device__ __forceinline__ bool next(int i, Unit& u) const {
        const int L = i * G + v; if (L >= 256) return false;
        const int x = L >> 5, j = L & 31, pm = j & 7, rest = x * 4 + (j >> 3), which = rest & 1, bg = rest >> 1;
        u.pm = pm; u.pn = which; u.z = bg; u.A = A + (size_t)pm * (256 * (size_t)8192 * 2) + (size_t)which * 8192; u.B = T + (size_t)bg * (256 * (size_t)8192 * 2) + (size_t)which * 8192; return true;
    }
};

__device__ __forceinline__ float rstd_of(float ss) { return rsqrtf(ss * (1.0f / D) + 1e-6f); }
struct EpiSwiglu {
    static constexpr bool PERM = true; static constexpr bool AFTER_DRAIN = false;
    unsigned char* ws; int ss_off, cb_off;
    __device__ __forceinline__ void operator()(const f32x4 (&acc)[2][2][4][2], const Unit& u, int wr, int wc, int fr, int fq) const {
        const int row0 = u.pm * 256 + wr * 64 + fr, col0 = u.pn * 128 + wc * 32 + 8 * fq;
        const int mb = u.pm < 64 ? (u.pm >> 4) : 4;
        bf16_t* O = (bf16_t*)(ws + WS_ACT); const float* SSc = (const float*)(ws + WS_SS) + ss_off;
        const float* cbp = (const float*)(ws + WS_CB) + cb_off + (size_t)mb * NFF1 + u.pn * 256 + wc * 32 + 8 * fq;
        const f32x4 cg0 = *(const f32x4*)cbp, cg1 = *(const f32x4*)(cbp + 4), cu0 = *(const f32x4*)(cbp + 128), cu1 = *(const f32x4*)(cbp + 132);
        float rr[2][4];
#pragma unroll
        for (int ai = 0; ai < 2; ++ai)
#pragma unroll
            for (int m = 0; m < 4; ++m) rr[ai][m] = SSc[row0 + ai * 128 + m * 16];
#pragma unroll
        for (int ai = 0; ai < 2; ++ai)
#pragma unroll
            for (int m = 0; m < 4; ++m) {
                const int row = row0 + ai * 128 + m * 16;
                const float r = rstd_of(rr[ai][m]);
                bf16_t* rowp = O + (size_t)row * DFF + col0;
                const f32x4 g0 = acc[ai][0][m][0] * r + cg0, g1 = acc[ai][0][m][1] * r + cg1, u0 = acc[ai][1][m][0] * r + cu0, u1 = acc[ai][1][m][1] * r + cu1;
                u32x4 w;
                w.x = cvt_pk_bf16(siluf_(g0[0]) * u0[0], siluf_(g0[1]) * u0[1]); w.y = cvt_pk_bf16(siluf_(g0[2]) * u0[2], siluf_(g0[3]) * u0[3]);
                w.z = cvt_pk_bf16(siluf_(g1[0]) * u1[0], siluf_(g1[1]) * u1[1]); w.w = cvt_pk_bf16(siluf_(g1[2]) * u1[2], siluf_(g1[3]) * u1[3]);
                ST16(0, rowp, w);
            }
    }
};
template <bool FUSE, bool INPLACE, bool HASBIAS> struct EpiResid {
    static constexpr bool PERM = true; static constexpr bool AFTER_DRAIN = false;
    unsigned char* ws; const float* base0; const float* base1; const float* bias; float gmul; int gate_off, ss_off, gn_off, scn_off;
    __device__ __forceinline__ void operator()(const f32x4 (&acc)[2][2][4][2], const Unit& u, int wr, int wc, int fr, int fq) const {
        const int row0 = u.pm * 256 + wr * 64 + fr, col0 = u.pn * 256 + wc * 32 + 8 * fq;
        const int mb = u.pm < 64 ? (u.pm >> 4) : 4;
        float* SSn = (float*)(ws + WS_SS) + ss_off;
        const float* gate = (const float*)(ws + WS_MOD) + gate_off + (size_t)mb * 9216; const float* gn = (const float*)(ws + WS_NG) + gn_off; const float* scn = (const float*)(ws + WS_MOD) + scn_off + (size_t)mb * 9216;
        f32x4 gv[2][2], bv[2][2], wv[2][2];
#pragma unroll
        for (int bj = 0; bj < 2; ++bj)
#pragma unroll
            for (int n = 0; n < 2; ++n) { const int cc = col0 + bj * 128 + 4 * n;
                gv[bj][n] = *(const f32x4*)(gate + cc) * gmul;
                bv[bj][n] = HASBIAS ? *(const f32x4*)(bias + cc) : (f32x4){0.f, 0.f, 0.f, 0.f};
                wv[bj][n] = FUSE ? *(const f32x4*)(gn + cc) * (*(const f32x4*)(scn + cc) + 1.0f) : (f32x4){0.f, 0.f, 0.f, 0.f}; }
        const unsigned e0 = (unsigned)(row0 * D + col0);
        const char* bsc = (const char*)base0; char* Hc = (char*)(ws + WS_H); char* HBc = (char*)(ws + WS_XN);
        constexpr int RGB = 2;
#pragma unroll
        for (int rg = 0; rg < 8 / RGB; ++rg) {
            u32x4 braw[INPLACE ? RGB : 1][2]; f32x4 bb[INPLACE ? 1 : RGB][2][2];
#pragma unroll
            for (int mm = 0; mm < RGB; ++mm) { const int q = rg * RGB + mm, ai = q >> 2, m = q & 3;
#pragma unroll
                for (int bj = 0; bj < 2; ++bj) { const unsigned e = e0 + (unsigned)((ai * 128 + m * 16) * D + bj * 128);
                    if constexpr (INPLACE) braw[mm][bj] = *(const u32x4*)(Hc + (size_t)(e * 2u));
                    else { bb[mm][bj][0] = *(const f32x4*)(bsc + (size_t)(e * 4u)); bb[mm][bj][1] = *(const f32x4*)(bsc + (size_t)(e * 4u + 16u)); } } }
#pragma unroll
            for (int mm = 0; mm < RGB; ++mm) { const int q = rg * RGB + mm, ai = q >> 2, m = q & 3; float ssum = 0.f;
#pragma unroll
                for (int bj = 0; bj < 2; ++bj) { const unsigned e = e0 + (unsigned)((ai * 128 + m * 16) * D + bj * 128);
                    f32x4 r0, r1;
                    if constexpr (INPLACE) { const u32x4 q4 = braw[mm][bj];
                        r0 = (f32x4){__uint_as_float(q4[0] << 16), __uint_as_float(q4[0] & 0xffff0000u), __uint_as_float(q4[1] << 16), __uint_as_float(q4[1] & 0xffff0000u)};
                        r1 = (f32x4){__uint_as_float(q4[2] << 16), __uint_as_float(q4[2] & 0xffff0000u), __uint_as_float(q4[3] << 16), __uint_as_float(q4[3] & 0xffff0000u)}; }
                    else { r0 = bb[mm][bj][0]; r1 = bb[mm][bj][1]; }
                    const f32x4 h0 = r0 + gv[bj][0] * (acc[ai][bj][m][0] + bv[bj][0]), h1 = r1 + gv[bj][1] * (acc[ai][bj][m][1] + bv[bj][1]);
                    { u32x4 w; w.x = cvt_pk_bf16(h0[0], h0[1]); w.y = cvt_pk_bf16(h0[2], h0[3]); w.z = cvt_pk_bf16(h1[0], h1[1]); w.w = cvt_pk_bf16(h1[2], h1[3]); ST16(1, Hc + (size_t)(e * 2u), w); }
                    if (FUSE) { ssum += ((h0[0] * h0[0] + h0[1] * h0[1]) + (h0[2] * h0[2] + h0[3] * h0[3])) + ((h1[0] * h1[0] + h1[1] * h1[1]) + (h1[2] * h1[2] + h1[3] * h1[3]));
                        const f32x4 z0 = h0 * wv[bj][0], z1 = h1 * wv[bj][1];
                        u32x4 w; w.x = cvt_pk_bf16(z0[0], z0[1]); w.y = cvt_pk_bf16(z0[2], z0[3]); w.z = cvt_pk_bf16(z1[0], z1[1]); w.w = cvt_pk_bf16(z1[2], z1[3]);
                        ST16(2, HBc + (size_t)(e * 2u), w); } }
                if (FUSE) { ssum += __shfl_xor(ssum, 16); ssum += __shfl_xor(ssum, 32); if (fq == 0) unsafeAtomicAdd(SSn + (unsigned)(row0 + ai * 128 + m * 16), ssum); } }
            asm volatile("" ::: "memory"); }
    }
};
struct EpiFinal {
    static constexpr bool PERM = true; static constexpr bool AFTER_DRAIN = true;
    unsigned char* ws; float* out; const float* fg; int gate_off;
    __device__ __forceinline__ void fused(f32x4 (&acc)[2][2][4][2], const Unit& u, int wr, int wc, int fr, int fq) const {
        const int row0 = u.pm * 256 + wr * 64 + fr, col0 = u.pn * 256 + wc * 32 + 8 * fq;
        const int mb = u.pm >> 4;
        const char* Hc = (const char*)(ws + WS_H); float* SSF = (float*)(ws + WS_SSF); unsigned* cnt = (unsigned*)(ws + WS_CNTF) + 64 * u.pm;
        const float* gate = (const float*)(ws + WS_MOD) + gate_off + (size_t)mb * 9216;
        const unsigned e0 = (unsigned)(row0 * D + col0);
        {
            f32x4 gv[2][2];
#pragma unroll
            for (int bj = 0; bj < 2; ++bj)
#pragma unroll
                for (int n = 0; n < 2; ++n) gv[bj][n] = *(const f32x4*)(gate + col0 + bj * 128 + 4 * n) * 0.5f;
#pragma unroll
            for (int rg = 0; rg < 4; ++rg) {
                u32x4 braw[2][2];
#pragma unroll
                for (int mm = 0; mm < 2; ++mm) { const int q = rg * 2 + mm, ai = q >> 2, m = q & 3;
#pragma unroll
                    for (int bj = 0; bj < 2; ++bj) { const unsigned e = e0 + (unsigned)((ai * 128 + m * 16) * D + bj * 128); braw[mm][bj] = *(const u32x4*)(Hc + (size_t)(e * 2u)); } }
#pragma unroll
                for (int mm = 0; mm < 2; ++mm) { const int q = rg * 2 + mm, ai = q >> 2, m = q & 3; float ssum = 0.f;
#pragma unroll
                    for (int bj = 0; bj < 2; ++bj) { const u32x4 q4 = braw[mm][bj];
                        const f32x4 r0 = (f32x4){__uint_as_float(q4[0] << 16), __uint_as_float(q4[0] & 0xffff0000u), __uint_as_float(q4[1] << 16), __uint_as_float(q4[1] & 0xffff0000u)};
                        const f32x4 r1 = (f32x4){__uint_as_float(q4[2] << 16), __uint_as_float(q4[2] & 0xffff0000u), __uint_as_float(q4[3] << 16), __uint_as_float(q4[3] & 0xffff0000u)};
                        const f32x4 h0 = r0 + gv[bj][0] * acc[ai][bj][m][0], h1 = r1 + gv[bj][1] * acc[ai][bj][m][1]; acc[ai][bj][m][0] = h0; acc[ai][bj][m][1] = h1;
                        ssum += ((h0[0] * h0[0] + h0[1] * h0[1]) + (h0[2] * h0[2] + h0[3] * h0[3])) + ((h1[0] * h1[0] + h1[1] * h1[1]) + (h1[2] * h1[2] + h1[3] * h1[3])); }
                    ssum += __shfl_xor(ssum, 16); ssum += __shfl_xor(ssum, 32);
                    if (fq == 0) unsafeAtomicAdd(SSF + (unsigned)(row0 + ai * 128 + m * 16), ssum); }
                asm volatile("" ::: "memory"); }
        }
        asm volatile("s_waitcnt vmcnt(0)" ::: "memory");
        if ((threadIdx.x & 63) == 0) __hip_atomic_fetch_add(cnt, 1u, __ATOMIC_RELAXED, __HIP_MEMORY_SCOPE_AGENT);
        { unsigned spins = 0;
          while ((unsigned)__builtin_amdgcn_readfirstlane(__hip_atomic_load(cnt, __ATOMIC_RELAXED, __HIP_MEMORY_SCOPE_AGENT)) < 32u) { __builtin_amdgcn_s_sleep(2); if (++spins > (1u << 22)) break; } }
        float rr[2][4];
#pragma unroll
        for (int ai = 0; ai < 2; ++ai)
#pragma unroll
            for (int m = 0; m < 4; ++m) rr[ai][m] = rstd_of(__hip_atomic_load(SSF + (unsigned)(row0 + ai * 128 + m * 16), __ATOMIC_RELAXED, __HIP_MEMORY_SCOPE_AGENT));
        f32x4 fv[2][2];
#pragma unroll
        for (int bj = 0; bj < 2; ++bj)
#pragma unroll
            for (int n = 0; n < 2; ++n) fv[bj][n] = *(const f32x4*)(fg + col0 + bj * 128 + 4 * n);
#pragma unroll
        for (int ai = 0; ai < 2; ++ai)
#pragma unroll
            for (int m = 0; m < 4; ++m)
#pragma unroll
                for (int bj = 0; bj < 2; ++bj) { const unsigned e = e0 + (unsigned)((ai * 128 + m * 16) * D + bj * 128);
                    *(f32x4*)((char*)out + (size_t)(e * 4u)) = acc[ai][bj][m][0] * rr[ai][m] * fv[bj][0]; *(f32x4*)((char*)out + (size_t)(e * 4u + 16u)) = acc[ai][bj][m][1] * rr[ai][m] * fv[bj][1]; }
    }
    __device__ __forceinline__ void operator()(const f32x4 (&)[2][2][4][2], const Unit&, int, int, int, int) const {}
};
struct EpiCtxAtomic {
    static constexpr bool PERM = false; static constexpr bool AFTER_DRAIN = false;
    float* H; const float* gate; float gmul;
    __device__ __forceinline__ void operator()(const f32x4 (&acc)[2][2][4][2], const Unit& u, int wr, int wc, int fr, int fq) const {
        const int row0 = u.pm * 256 + wr * 64 + fr, col0 = u.pn * 256 + wc * 32 + 4 * fq;
#pragma unroll
        for (int bj = 0; bj < 2; ++bj)
#pragma unroll
            for (int n = 0; n < 2; ++n) { const f32x4 gv = *(const f32x4*)(gate + col0 + bj * 128 + n * 16) * gmul;
#pragma unroll
                for (int ai = 0; ai < 2; ++ai)
#pragma unroll
                    for (int m = 0; m < 4; ++m) { float* o = H + (size_t)(row0 + ai * 128 + m * 16) * D + col0 + bj * 128 + n * 16; const f32x4 v = gv * acc[ai][bj][m][n];
#pragma unroll
                        for (int i = 0; i < 4; ++i) unsafeAtomicAdd(o + i, v[i]); } }
    }
};
struct EpiMixIn {
    static constexpr bool PERM = true; static constexpr bool AFTER_DRAIN = false;
    unsigned char* ws; int ss_off;
    __device__ __forceinline__ void operator()(const f32x4 (&accr)[2][2][4][2], const Unit& u, int wr, int wc, int fr, int fq) const {
        const int row0 = u.pm * 256 + wr * 64 + fr;
        f32x4 acc[2][2][4][2];
        bf16_t *YG = (bf16_t*)(ws + WS_YG), *QB = (bf16_t*)(ws + WS_QB), *KB = (bf16_t*)(ws + WS_KB), *VTL = (bf16_t*)(ws + WS_VTL), *VTC = (bf16_t*)(ws + WS_VTC);
        const float* SSc = (const float*)(ws + WS_SS) + ss_off;
        { const int mb = u.pm < 64 ? (u.pm >> 4) : 4; const float* cbp = (const float*)(ws + WS_CBAB) + (size_t)mb * NAB + u.pn * 256 + wc * 32 + 8 * fq;
          f32x4 cv[2][2];
#pragma unroll
          for (int bj = 0; bj < 2; ++bj)
#pragma unroll
              for (int n = 0; n < 2; ++n) cv[bj][n] = *(const f32x4*)(cbp + bj * 128 + 4 * n);
#pragma unroll
          for (int ai = 0; ai < 2; ++ai)
#pragma unroll
              for (int m = 0; m < 4; ++m) { const float r = rstd_of(SSc[row0 + ai * 128 + m * 16]);
#pragma unroll
                  for (int bj = 0; bj < 2; ++bj)
#pragma unroll
                      for (int n = 0; n < 2; ++n) acc[ai][bj][m][n] = accr[ai][bj][m][n] * r + cv[bj][n]; } }
        if (u.pn < 4) {
            const int col0 = u.pn * 128 + wc * 32 + 8 * fq;
#pragma unroll
            for (int ai = 0; ai < 2; ++ai)
#pragma unroll
                for (int m = 0; m < 4; ++m) {
                    const f32x4 a0 = acc[ai][0][m][0], a1 = acc[ai][0][m][1], g0 = acc[ai][1][m][0], g1 = acc[ai][1][m][1];
                    u32x4 w;
                    w.x = cvt_pk_bf16(a0[0] * sigmoidf_(g0[0]), a0[1] * sigmoidf_(g0[1])); w.y = cvt_pk_bf16(a0[2] * sigmoidf_(g0[2]), a0[3] * sigmoidf_(g0[3]));
                    w.z = cvt_pk_bf16(a1[0] * sigmoidf_(g1[0]), a1[1] * sigmoidf_(g1[1])); w.w = cvt_pk_bf16(a1[2] * sigmoidf_(g1[2]), a1[3] * sigmoidf_(g1[3]));
                    ST16(3, YG + (size_t)(row0 + ai * 128 + m * 16) * 512 + col0, w);
                }
        } else if (u.pn < 8) {
            const bool isq = u.pn < 6; bf16_t* O = isq ? QB : KB; const float s = isq ? 0.125f : 1.0f;
            const int col0 = ((u.pn - 4) & 1) * 256 + wc * 32 + 8 * fq;
#pragma unroll
            for (int ai = 0; ai < 2; ++ai)
#pragma unroll
                for (int m = 0; m < 4; ++m)
#pragma unroll
                    for (int bj = 0; bj < 2; ++bj) {
                        const f32x4 v0 = acc[ai][bj][m][0] * s, v1 = acc[ai][bj][m][1] * s;
                        u32x4 w; w.x = cvt_pk_bf16(v0[0], v0[1]); w.y = cvt_pk_bf16(v0[2], v0[3]); w.z = cvt_pk_bf16(v1[0], v1[1]); w.w = cvt_pk_bf16(v1[2], v1[3]);
                        ST16(3, O + (size_t)(row0 + ai * 128 + m * 16) * 512 + col0 + bj * 128, w);
                    }
        } else {
            const int col0 = (u.pn - 8) * 256 + wc * 32 + 8 * fq;
#pragma unroll
            for (int ai = 0; ai < 2; ++ai)
#pragma unroll
                for (int m = 0; m < 4; ++m) {
                    const int row = row0 + ai * 128 + m * 16;
                    bf16_t* base; size_t dstride;
                    if (u.pm < 64) { const int b = row >> 12, n = row & 4095; base = VTL + (size_t)b * (512 * 4096) + n; dstride = 4096; }
                    else { const int rr = row - NTOK, b = rr >> 8, j = rr & 255; base = VTC + (size_t)b * (512 * 256) + j; dstride = 256; }
#pragma unroll
                    for (int bj = 0; bj < 2; ++bj)
#pragma unroll
                        for (int n = 0; n < 2; ++n)
#pragma unroll
                            for (int i = 0; i < 4; ++i) { const int c = col0 + bj * 128 + 4 * n + i;
                                const unsigned pk = cvt_pk_bf16(acc[ai][bj][m][n][i], 0.f);
                                PL2(base + (size_t)c * dstride, pk & 0xffffu); }
                }
        }
    }
};
struct EpiDftA {
    static constexpr bool PERM = true; static constexpr bool AFTER_DRAIN = false;
    unsigned char* ws; int ss_off;
    __device__ __forceinline__ void operator()(const f32x4 (&acc)[2][2][4][2], const Unit& u, int wr, int wc, int fr, int fq) const {
        const int rt0 = wr * 64 + fr, pcol0 = u.pn * 256 + wc * 32 + 8 * fq, col0 = u.pm * 4096 + pcol0;
        const int b = u.z >> 2, gr = u.z & 3;
        const float* SSc = (const float*)(ws + WS_SS) + ss_off; const float* cbd = (const float*)(ws + WS_CBD);
        bf16_t* tb = (bf16_t*)(ws + WS_T) + (size_t)u.z * (256 * (size_t)8192);
        f32x4 rc[2][2];
#pragma unroll
        for (int bj = 0; bj < 2; ++bj)
#pragma unroll
            for (int n = 0; n < 2; ++n) { const f32x4 sv = *(const f32x4*)(SSc + b * SEQ + pcol0 + bj * 128 + 4 * n);
                rc[bj][n] = (f32x4){rstd_of(sv[0]), rstd_of(sv[1]), rstd_of(sv[2]), rstd_of(sv[3])}; }
        float cmv[2][4];
#pragma unroll
        for (int ai = 0; ai < 2; ++ai)
#pragma unroll
            for (int m = 0; m < 4; ++m) cmv[ai][m] = cbd[(b * 4 + gr) * 512 + u.pm * 256 + rt0 + ai * 128 + m * 16];
#pragma unroll
        for (int ai = 0; ai < 2; ++ai)
#pragma unroll
            for (int m = 0; m < 4; ++m) {
                const int rt = rt0 + ai * 128 + m * 16; const float cm = cmv[ai][m];
#pragma unroll
                for (int bj = 0; bj < 2; ++bj) {
                    const f32x4 v0 = acc[ai][bj][m][0] * rc[bj][0] + cm, v1 = acc[ai][bj][m][1] * rc[bj][1] + cm;
                    u32x4 w; w.x = cvt_pk_bf16(v0[0], v0[1]); w.y = cvt_pk_bf16(v0[2], v0[3]); w.z = cvt_pk_bf16(v1[0], v1[1]); w.w = cvt_pk_bf16(v1[2], v1[3]);
                    ST16(4, tb + (size_t)rt * 8192 + col0 + bj * 128, w);
                } }
    }
};
typedef __amdgpu_buffer_rsrc_t rsrc_t;
struct EpiDftX {
    static constexpr bool PERM = true; static constexpr bool AFTER_DRAIN = true;
    unsigned char* ws;
    __device__ __forceinline__ void operator()(const f32x4 (&)[2][2][4][2], const Unit&, int, int, int, int) const {}
    __device__ __forceinline__ void fused(f32x4 (&acc)[2][2][4][2], const Unit& u, int wr, int wc, int fr, int fq) const {
        const int which = u.pn, bg = u.z, b = bg >> 2, gr = bg & 3, lane = threadIdx.x & 63, wave = threadIdx.x >> 6;
        const int row0 = u.pm * 256 + wr * 64 + fr, col0 = wc * 32 + 8 * fq;
        const rsrc_t rs = __builtin_amdgcn_make_buffer_rsrc((void*)ws, (short)0, (int)WS_TOTAL, 0x00020000);
        const unsigned own = (unsigned)(WS_XN + (size_t)(which * 16 + bg) * (2048 * 256) * 2), par = (unsigned)(WS_XN + (size_t)((1 - which) * 16 + bg) * (2048 * 256) * 2);
#pragma unroll
        for (int ai = 0; ai < 2; ++ai)
#pragma unroll
            for (int m = 0; m < 4; ++m)
#pragma unroll
                for (int bj = 0; bj < 2; ++bj) {
                    const f32x4 v0 = acc[ai][bj][m][0], v1 = acc[ai][bj][m][1];
                    u32x4 w; w.x = cvt_pk_bf16(v0[0], v0[1]); w.y = cvt_pk_bf16(v0[2], v0[3]); w.z = cvt_pk_bf16(v1[0], v1[1]); w.w = cvt_pk_bf16(v1[2], v1[3]);
                    __builtin_amdgcn_raw_buffer_store_b128(w, rs, own + (unsigned)(((row0 + ai * 128 + m * 16) * 256 + col0 + bj * 128) * 2), 0, 16);
                }
        asm volatile("s_waitcnt vmcnt(0)" ::: "memory");
        unsigned* cnt = (unsigned*)(ws + WS_CNTX) + 64 * (bg * 8 + u.pm);
        if (lane == 0) __hip_atomic_fetch_add(cnt, 1u, __ATOMIC_RELAXED, __HIP_MEMORY_SCOPE_AGENT);
        { unsigned spins = 0;
          while ((unsigned)__builtin_amdgcn_readfirstlane(__hip_atomic_load(cnt, __ATOMIC_RELAXED, __HIP_MEMORY_SCOPE_AGENT)) < 16u) { __builtin_amdgcn_s_sleep(2); if (++spins > (1u << 22)) break; } }
        bf16_t* F = (bf16_t*)(ws + WS_F);
#pragma unroll
        for (int ai = 0; ai < 2; ++ai)
#pragma unroll
            for (int m = 0; m < 4; ++m) {
                const int k = row0 + ai * 128 + m * 16, rout = which ? (SEQ - k) : k;
#pragma unroll
                for (int bj = 0; bj < 2; ++bj) {
                    const u32x4 pv = __builtin_amdgcn_raw_buffer_load_b128(rs, par + (unsigned)((k * 256 + col0 + bj * 128) * 2), 0, 16);
                    const f32x4 a0 = acc[ai][bj][m][0], a1 = acc[ai][bj][m][1];
                    const f32x4 p0 = (f32x4){__uint_as_float(pv[0] << 16), __uint_as_float(pv[0] & 0xffff0000u), __uint_as_float(pv[1] << 16), __uint_as_float(pv[1] & 0xffff0000u)};
                    const f32x4 p1 = (f32x4){__uint_as_float(pv[2] << 16), __uint_as_float(pv[2] & 0xffff0000u), __uint_as_float(pv[3] << 16), __uint_as_float(pv[3] & 0xffff0000u)};
                    const f32x4 o0 = which ? (p0 - a0) : (a0 + p0), o1 = which ? (p1 - a1) : (a1 + p1);
                    u32x4 w; w.x = cvt_pk_bf16(o0[0], o0[1]); w.y = cvt_pk_bf16(o0[2], o0[3]); w.z = cvt_pk_bf16(o1[0], o1[1]); w.w = cvt_pk_bf16(o1[2], o1[3]);
                    if (!(which && k == 0)) ST16(5, F + ((size_t)b * SEQ + rout) * D + gr * 256 + col0 + bj * 128, w);
                } }
        const bf16_t* T = (const bf16_t*)(ws + WS_T);
#pragma unroll
        for (int t = 0; t < 2; ++t) {
            const int m = (which * 8 + u.pm) * 16 + wave * 2 + t;
            const bf16_t* tp = T + ((size_t)bg * 256 + m) * 8192 + lane * 64;
            float sacc = 0.f;
#pragma unroll
            for (int j = 0; j < 8; ++j) { const u32x4 v = *(const u32x4*)(tp + 8 * j);
#pragma unroll
                for (int e = 0; e < 4; ++e) sacc += __uint_as_float(v[e] << 16) - __uint_as_float(v[e] & 0xffff0000u); }
            sacc = wave_sum(sacc) * 0.015625f;
            if (lane == 0) F[((size_t)b * SEQ + 2048) * D + gr * 256 + m] = (bf16_t)(cvt_pk_bf16(sacc, 0.f) & 0xffffu);
        }
    }
};

struct Params { const float* in[19]; float* out; unsigned char* ws; };
enum { I_X = 0, I_C, I_CTX, I_CCTX, I_ADAW, I_ADAB, I_NORMG, I_FFNWIN, I_FFNWOUT, I_ABWIN, I_CONVW, I_CONVB, I_CONVLNG, I_CONVLNB, I_RPB, I_ABWOUT, I_FNETW, I_FNETB, I_FINALG };

__device__ __forceinline__ void transpose_item(const float* W, int K, int N, bf16_t* WT, int n0src, int n0dst, int k0, LAS float* scr, int lane) {
    float v[32];
#pragma unroll
    for (int i = 0; i < 32; ++i) { const int kk = 2 * i + (lane >> 5); v[i] = W[(size_t)(k0 + kk) * N + n0src + (lane & 31)]; }
#pragma unroll
    for (int i = 0; i < 32; ++i) { const int kk = 2 * i + (lane >> 5); scr[kk * 33 + (lane & 31)] = v[i]; }
    asm volatile("s_waitcnt lgkmcnt(0)" ::: "memory");
    const int c = lane & 7;
#pragma unroll
    for (int j = 0; j < 4; ++j) { const int n = (lane >> 3) + 8 * j; const LAS float* s = scr + (8 * c) * 33 + n;
        u32x4 o; o.x = cvt_pk_bf16(s[0 * 33], s[1 * 33]); o.y = cvt_pk_bf16(s[2 * 33], s[3 * 33]); o.z = cvt_pk_bf16(s[4 * 33], s[5 * 33]); o.w = cvt_pk_bf16(s[6 * 33], s[7 * 33]);
        ST16(6, WT + (size_t)(n0dst + n) * K + k0 + 8 * c, o); }
    asm volatile("s_waitcnt lgkmcnt(0)" ::: "memory");
}
__device__ __forceinline__ int paired_src(int n0d, int Hs) { const int t = n0d >> 8, cp = n0d & 255; return cp < 128 ? t * 128 + cp : Hs + t * 128 + (cp - 128); }

__device__ __forceinline__ void gen_dftl(unsigned char* ws, LAS unsigned char* lds, int first) {
    const int tid = threadIdx.x, lane = tid & 63, wave = tid >> 6, nb = (int)gridDim.x - first, bi = (int)blockIdx.x - first;
    if (bi < 0) return;
    LAS float* lut = (LAS float*)lds;
    for (int i = tid; i < 4096; i += 512) lut[i] = cospif((float)i * (1.0f / 2048.0f));
    __syncthreads();
    bf16_t* DL = (bf16_t*)(ws + WS_DFTL);
    for (int k = bi * 8 + wave; k < 2048; k += nb * 8) {
        float cj[8], sj[8];
#pragma unroll
        for (int j = 0; j < 8; ++j) { const int idx = (k * j) & 4095; cj[j] = lut[idx] * 0.015625f; sj[j] = lut[(idx - 1024) & 4095] * 0.015625f; }
#pragma unroll
        for (int i = 0; i < 8; ++i) { const int n0 = 8 * (lane + 64 * i), idx0 = (k * n0) & 4095; const float c0 = lut[idx0], s0 = lut[(idx0 - 1024) & 4095]; float vc[8], vs[8];
#pragma unroll
            for (int j = 0; j < 8; ++j) { vc[j] = c0 * cj[j] - s0 * sj[j]; vs[j] = s0 * cj[j] + c0 * sj[j]; }
            u32x4 o; o.x = cvt_pk_bf16(vc[0], vc[1]); o.y = cvt_pk_bf16(vc[2], vc[3]); o.z = cvt_pk_bf16(vc[4], vc[5]); o.w = cvt_pk_bf16(vc[6], vc[7]);
            ST16(6, DL + (size_t)k * 8192 + n0, o);
            o.x = cvt_pk_bf16(vs[0], vs[1]); o.y = cvt_pk_bf16(vs[2], vs[3]); o.z = cvt_pk_bf16(vs[4], vs[5]); o.w = cvt_pk_bf16(vs[6], vs[7]);
            ST16(6, DL + (size_t)k * 8192 + 4096 + n0, o); }
    }
    __syncthreads();
}

__device__ __forceinline__ void prologue(const Params& p, LAS unsigned char* lds) {
    const int tid = threadIdx.x, lane = tid & 63, wave = tid >> 6, G = gridDim.x;
    unsigned char* ws = p.ws;
    {
        LAS float* sil = (LAS float*)lds;
        LAS float* part = (LAS float*)(lds + 20480);
        for (int i = tid; i < 5 * 1024; i += 512) { const int b = i >> 10, k = i & 1023; const float v = (b < 4) ? p.in[I_C][b * 1024 + k] : p.in[I_CCTX][k]; sil[i] = v / (1.0f + __expf(-v)); }
        __syncthreads();
        float* MOD = (float*)(ws + WS_MOD);
        const int cl = tid & 7, kr = tid >> 3;
        for (int item = blockIdx.x; item < 576; item += G) {
            const int l = item / 288, n0 = (item % 288) * 32;
            const float* wp = p.in[I_ADAW] + (size_t)l * 1024 * 9216 + n0 + 4 * cl;
            f32x4 acc[5];
#pragma unroll
            for (int b = 0; b < 5; ++b) acc[b] = (f32x4){0.f, 0.f, 0.f, 0.f};
#pragma unroll
            for (int s = 0; s < 16; ++s) { const int k = kr + 64 * s; const f32x4 w4 = *(const f32x4*)(wp + (size_t)k * 9216);
#pragma unroll
                for (int b = 0; b < 5; ++b) acc[b] += w4 * sil[b * 1024 + k]; }
#pragma unroll
            for (int b = 0; b < 5; ++b)
#pragma unroll
                for (int q = 0; q < 4; ++q) { float v = acc[b][q]; v += __shfl_xor(v, 8); v += __shfl_xor(v, 16); v += __shfl_xor(v, 32); acc[b][q] = v; }
            if (lane < 8) {
#pragma unroll
                for (int b = 0; b < 5; ++b)
#pragma unroll
                    for (int q = 0; q < 4; ++q) part[(wave * 5 + b) * 32 + 4 * lane + q] = acc[b][q];
            }
            __syncthreads();
            if (tid < 160) { const int b = tid >> 5, col = tid & 31; float s = p.in[I_ADAB][l * 9216 + n0 + col];
#pragma unroll
                for (int w = 0; w < 8; ++w) s += part[(w * 5 + b) * 32 + col];
                MOD[(size_t)(l * 5 + b) * 9216 + n0 + col] = s; }
            __syncthreads();
        }
    }
    __syncthreads();
    {
        LAS float* scr = (LAS float*)(lds + wave * 16384);
        const int gw = blockIdx.x * 8 + wave, NGW = G * 8;
        constexpr int I_W1 = 16 * 176, I_W2 = 44 * 32, I_AB = 16 * 80, I_SQ = 16 * 32;
        constexpr int NITEMS = 4 * I_W1 + 4 * I_W2 + I_AB + 2 * I_SQ;
        for (int it = gw; it < NITEMS; it += NGW) {
            int r = it;
            if (r < 4 * I_W1) { const int mi = r / I_W1; r -= mi * I_W1; const int kb = r / 176, nb = r % 176;
                transpose_item(p.in[I_FFNWIN] + (size_t)mi * D * NFF1, D, NFF1, (bf16_t*)(ws + WS_W1T + mi * SZ_W1T), paired_src(nb * 32, DFF), nb * 32, kb * 64, scr, lane); continue; }
            r -= 4 * I_W1;
            if (r < 4 * I_W2) { const int mi = r / I_W2; r -= mi * I_W2; const int kb = r / 32, nb = r % 32;
                transpose_item(p.in[I_FFNWOUT] + (size_t)mi * DFF * D, DFF, D, (bf16_t*)(ws + WS_W2T + mi * SZ_W2T), nb * 32, nb * 32, kb * 64, scr, lane); continue; }
            r -= 4 * I_W2;
            if (r < I_AB) { const int kb = r / 80, nb = r % 80; const int nd = nb * 32, nsrc = nd < 1024 ? paired_src(nd, 512) : nd;
                transpose_item(p.in[I_ABWIN], D, NAB, (bf16_t*)(ws + WS_WABT), nsrc, nd, kb * 64, scr, lane); continue; }
            r -= I_AB;
            if (r < I_SQ) { const int kb = r / 32, nb = r % 32; transpose_item(p.in[I_ABWOUT], D, D, (bf16_t*)(ws + WS_WOT), nb * 32, nb * 32, kb * 64, scr, lane); continue; }
            r -= I_SQ;
            { const int kb = r / 32, nb = r % 32; transpose_item(p.in[I_FNETW], D, D, (bf16_t*)(ws + WS_WFT), nb * 32, nb * 32, kb * 64, scr, lane); }
        }
    }
    __syncthreads();
    {
        LAS float* lut = (LAS float*)lds;
        for (int i = tid; i < 4096; i += 512) lut[i] = cospif((float)i * (1.0f / 2048.0f));
        __syncthreads();
        const int gt = blockIdx.x * 512 + tid, NT = G * 512;
        bf16_t* DC = (bf16_t*)(ws + WS_DFTC);
        for (int ch = gt; ch < 512 * 32; ch += NT) { const int mrow = ch >> 5, c0 = (ch & 31) * 8, m = mrow & 255, sp = mrow >> 8; float v[8];
#pragma unroll
            for (int j = 0; j < 8; ++j) { const int idx = ((m * (c0 + j)) & 255) * 16; v[j] = sp ? -lut[(idx - 1024) & 4095] * 0.0625f : lut[idx] * 0.0625f; }
            u32x4 o; o.x = cvt_pk_bf16(v[0], v[1]); o.y = cvt_pk_bf16(v[2], v[3]); o.z = cvt_pk_bf16(v[4], v[5]); o.w = cvt_pk_bf16(v[6], v[7]);
            *(u32x4*)(DC + (size_t)mrow * 256 + c0) = o; }
        { float* SS = (float*)(ws + WS_SS); for (int i = gt; i < 6 * MT; i += NT) SS[i] = 0.f; }
        { float* z = (float*)(ws + WS_SSF); for (int i = gt; i < (64 + 16 + 32) * 256; i += NT) z[i] = 0.f; }
        { float* ng = (float*)(ws + WS_NG); for (int i = gt; i < 6 * D; i += NT) ng[i] = p.in[I_NORMG][i]; }
        { float* Hc = (float*)(ws + WS_HC); const f32x4* src = (const f32x4*)p.in[I_CTX];
          for (int i = gt; i < NCTX * D / 4; i += NT) ((f32x4*)Hc)[i] = src[i]; }
    }
    __syncthreads();
}

__device__ __forceinline__ void prenorm_rows(const float* src0, const float* src1, int row_lo, int row_hi, const float* g, const float* scale, float* SS, bf16_t* HB) {
    const int lane = threadIdx.x & 63, wave = threadIdx.x >> 6, gw = blockIdx.x * 8 + wave, NGW = gridDim.x * 8;
    for (int row = row_lo + gw; row < row_hi; row += 2 * NGW) {
        const int rowb = row + NGW; const bool hasb = rowb < row_hi; const int rb = hasb ? rowb : row;
        const float* srca = row < NTOK ? src0 + (size_t)row * D : src1 + (size_t)(row - NTOK) * D;
        const float* srcb = rb < NTOK ? src0 + (size_t)rb * D : src1 + (size_t)(rb - NTOK) * D;
        const int mba = row < NTOK ? (row >> 12) : 4, mbb = rb < NTOK ? (rb >> 12) : 4;
        const f32x4* xa = (const f32x4*)srca + lane; const f32x4* xb = (const f32x4*)srcb + lane;
        f32x4 va[4], vb[4]; float sa = 0.f, sb = 0.f;
#pragma unroll
        for (int j = 0; j < 4; ++j) { va[j] = xa[64 * j]; vb[j] = xb[64 * j]; }
#pragma unroll
        for (int j = 0; j < 4; ++j) { sa += (va[j][0] * va[j][0] + va[j][1] * va[j][1]) + (va[j][2] * va[j][2] + va[j][3] * va[j][3]); sb += (vb[j][0] * vb[j][0] + vb[j][1] * vb[j][1]) + (vb[j][2] * vb[j][2] + vb[j][3] * vb[j][3]); }
        sa = wave_sum(sa); sb = wave_sum(sb);
        if (lane == 0) { SS[row] = sa; if (hasb) SS[rowb] = sb; }
        const f32x4* gp = (const f32x4*)g + lane;
        const f32x4* sca = (const f32x4*)(scale + (size_t)mba * 9216) + lane; const f32x4* scb = (const f32x4*)(scale + (size_t)mbb * 9216) + lane;
        u32x2* oa = (u32x2*)(HB + (size_t)row * D) + lane; u32x2* ob = (u32x2*)(HB + (size_t)rb * D) + lane;
#pragma unroll
        for (int j = 0; j < 4; ++j) { const f32x4 gj = gp[64 * j]; const f32x4 za = va[j] * gj * (sca[64 * j] + 1.0f), zb = vb[j] * gj * (scb[64 * j] + 1.0f);
            u32x2 w; w.x = cvt_pk_bf16(za[0], za[1]); w.y = cvt_pk_bf16(za[2], za[3]); oa[64 * j] = w;
            if (hasb) { w.x = cvt_pk_bf16(zb[0], zb[1]); w.y = cvt_pk_bf16(zb[2], zb[3]); ob[64 * j] = w; } }
    }
}
__device__ __forceinline__ void cb_item(const bf16_t* WT, int ldw, int K, int n0, const float* shift, float* out, int ostride, int lane) {
    const bf16_t* wp = WT + (size_t)(n0 + lane) * ldw;
    float a[5] = {0.f, 0.f, 0.f, 0.f, 0.f};
#pragma unroll 4
    for (int k8 = 0; k8 < K; k8 += 8) {
        const u32x4 q = *(const u32x4*)(wp + k8);
        float w[8];
#pragma unroll
        for (int e = 0; e < 4; ++e) { w[2 * e] = __uint_as_float(q[e] << 16); w[2 * e + 1] = __uint_as_float(q[e] & 0xffff0000u); }
#pragma unroll
        for (int b = 0; b < 5; ++b) { const float* sp = shift + (size_t)b * 9216 + k8;
#pragma unroll
            for (int e = 0; e < 8; ++e) a[b] += w[e] * sp[e]; }
    }
#pragma unroll
    for (int b = 0; b < 5; ++b) out[(size_t)b * ostride + n0 + lane] = a[b];
}
__device__ __forceinline__ void cb_tables(const Params& p) {
    const int lane = threadIdx.x & 63, wave = threadIdx.x >> 6, G = gridDim.x;
    unsigned char* ws = p.ws; const float* MOD = (const float*)(ws + WS_MOD);
    for (int it = blockIdx.x + G * wave; it < 4 * 88 + 40 + 32; it += 8 * G) {
        if (it < 352) { const int mi = it / 88, ch = it % 88, layer = mi >> 1, sub = mi & 1;
            cb_item((const bf16_t*)(ws + WS_W1T + mi * SZ_W1T), D, D, ch * 64, MOD + (size_t)layer * 5 * 9216 + (sub ? 6 : 0) * 1024, (float*)(ws + WS_CB) + (size_t)mi * 5 * NFF1, NFF1, lane); }
        else if (it < 392) { const int ch = it - 352; cb_item((const bf16_t*)(ws + WS_WABT), D, D, ch * 64, MOD + 3 * 1024, (float*)(ws + WS_CBAB), NAB, lane); }
        else { const int e = it - 392, gr = e >> 3, ch = e & 7;
            cb_item((const bf16_t*)(ws + WS_DFTC), 256, 256, ch * 64, MOD + (size_t)5 * 9216 + 3 * 1024 + gr * 256, (float*)(ws + WS_CBD) + gr * 512, 2048, lane); }
    }
}
__device__ __forceinline__ void final_norm_phase(const float* H, const float* g, float* out) {
    const int lane = threadIdx.x & 63, wave = threadIdx.x >> 6, gw = blockIdx.x * 8 + wave, NGW = gridDim.x * 8;
    for (int row = gw; row < NTOK; row += NGW) {
        const f32x4* xr = (const f32x4*)(H + (size_t)row * D) + lane;
        f32x4 v[4]; float s = 0.f;
#pragma unroll
        for (int j = 0; j < 4; ++j) { v[j] = xr[64 * j]; s += (v[j][0] * v[j][0] + v[j][1] * v[j][1]) + (v[j][2] * v[j][2] + v[j][3] * v[j][3]); }
        const float rstd = rsqrtf(wave_sum(s) * (1.0f / D) + 1e-6f);
        const f32x4* gp = (const f32x4*)g + lane; f32x4* o = (f32x4*)(out + (size_t)row * D) + lane;
#pragma unroll
        for (int j = 0; j < 4; ++j) o[64 * j] = v[j] * rstd * gp[64 * j];
    }
}

struct AttnState { float m, l; f32x4 o[4]; };
__device__ __forceinline__ void attn_group(AttnState& st, const bf16x8 (&kf)[4], const bf16x8 (&vf)[4], const bf16x8 q0, const bf16x8 q1, int cb, int w, const LAS float* rlrow, int g) {
    f32x4 a1 = (f32x4){0.f, 0.f, 0.f, 0.f}, a2 = (f32x4){0.f, 0.f, 0.f, 0.f};
    __builtin_amdgcn_s_setprio(1);
    a1 = __builtin_amdgcn_mfma_f32_16x16x32_bf16(kf[0], q0, a1, 0, 0, 0); a1 = __builtin_amdgcn_mfma_f32_16x16x32_bf16(kf[1], q1, a1, 0, 0, 0);
    a2 = __builtin_amdgcn_mfma_f32_16x16x32_bf16(kf[2], q0, a2, 0, 0, 0); a2 = __builtin_amdgcn_mfma_f32_16x16x32_bf16(kf[3], q1, a2, 0, 0, 0);
    __builtin_amdgcn_s_setprio(0);
    float s[8]; bool ok[8];
#pragma unroll
    for (int e = 0; e < 8; ++e) s[e] = e < 4 ? a1[e] : a2[e - 4];
    if (cb >= 0) {
        const int cs = min(max(w - 8, 0), 48);
#pragma unroll
        for (int e = 0; e < 8; ++e) { const int c = cb + 8 * g + e; ok[e] = (c >= cs) && (c < cs + 16); const int co = c - w + 15; const float bias = rlrow[ok[e] ? co : 0]; s[e] = ok[e] ? s[e] + bias : -1e30f; }
    } else {
#pragma unroll
        for (int e = 0; e < 8; ++e) ok[e] = true;
    }
    float mx = fmaxf(fmaxf(fmaxf(s[0], s[1]), fmaxf(s[2], s[3])), fmaxf(fmaxf(s[4], s[5]), fmaxf(s[6], s[7])));
    mx = fmaxf(mx, __shfl_xor(mx, 16)); mx = fmaxf(mx, __shfl_xor(mx, 32));
    const float mnew = fmaxf(st.m, mx), alpha = fast_exp(st.m - mnew);
    float pe[8], ps = 0.f;
#pragma unroll
    for (int e = 0; e < 8; ++e) { pe[e] = ok[e] ? fast_exp(s[e] - mnew) : 0.f; ps += pe[e]; }
    st.l = st.l * alpha + ps; st.m = mnew;
    union { u32x4 u; bf16x8 v; } pb;
    pb.u.x = cvt_pk_bf16(pe[0], pe[1]); pb.u.y = cvt_pk_bf16(pe[2], pe[3]); pb.u.z = cvt_pk_bf16(pe[4], pe[5]); pb.u.w = cvt_pk_bf16(pe[6], pe[7]);
#pragma unroll
    for (int dt = 0; dt < 4; ++dt) st.o[dt] = st.o[dt] * alpha;
    __builtin_amdgcn_s_setprio(1);
#pragma unroll
    for (int dt = 0; dt < 4; ++dt) st.o[dt] = __builtin_amdgcn_mfma_f32_16x16x32_bf16(vf[dt], pb.v, st.o[dt], 0, 0, 0);
    __builtin_amdgcn_s_setprio(0);
}

__device__ __forceinline__ void attn_unit(int u, const bf16_t* QB, const bf16_t* KB, const bf16_t* VTL, const bf16_t* VTC, const float* rpb, bf16_t* MIX, LAS float* rl, int lane) {
    const int r = u & 63, h = (u >> 6) & 7, b = u >> 9;
    const int rs = min(max(r - 4, 0), 56);
    const int qi = lane & 15, g = lane >> 4;
    for (int i = lane; i < 465; i += 64) { const int ro = i / 31, co = i - ro * 31; rl[ro * 32 + co] = rpb[h * 465 + i]; }
    asm volatile("s_waitcnt lgkmcnt(0)" ::: "memory");
    AttnState st[4];
    LAS bf16x8* qs = (LAS bf16x8*)(rl + 512) + lane;
#pragma unroll
    for (int qb = 0; qb < 4; ++qb) { st[qb].m = -1e30f; st[qb].l = 0.f;
#pragma unroll
        for (int dt = 0; dt < 4; ++dt) st[qb].o[dt] = (f32x4){0.f, 0.f, 0.f, 0.f};
        const size_t tq = (size_t)b * SEQ + r * 64 + 16 * qb + qi;
        qs[(qb * 2 + 0) * 64] = *(const bf16x8*)(QB + tq * 512 + h * 64 + 8 * g); qs[(qb * 2 + 1) * 64] = *(const bf16x8*)(QB + tq * 512 + h * 64 + 32 + 8 * g); }
    asm volatile("s_waitcnt lgkmcnt(0)" ::: "memory");
    const int kap = 8 * (qi >> 2) + (qi & 3);
    const bf16_t* vtl = VTL + ((size_t)(b * 8 + h) * 64 + qi) * 4096 + 8 * g;
    const bf16_t* vtc = VTC + ((size_t)(b * 8 + h) * 64 + qi) * 256 + 8 * g;
    const bf16_t* kl = KB + ((size_t)b * SEQ + kap) * 512 + h * 64 + 8 * g;
    const bf16_t* kc = KB + ((size_t)NTOK + b * 256 + kap) * 512 + h * 64 + 8 * g;
#define ATT_LOAD(kf, vf, kp, vp, vs) do { kf[0] = *(const bf16x8*)(kp); kf[1] = *(const bf16x8*)((kp) + 32); kf[2] = *(const bf16x8*)((kp) + 4 * 512); kf[3] = *(const bf16x8*)((kp) + 4 * 512 + 32); \
        _Pragma("unroll") for (int dt = 0; dt < 4; ++dt) vf[dt] = *(const bf16x8*)((vp) + (size_t)dt * (vs)); } while (0)
    bf16x8 kA[4], vA[4], kB[4], vB[4];
    ATT_LOAD(kA, vA, kl + (size_t)(rs * 64) * 512, vtl + rs * 64, 16 * 4096);
    for (int a = 0; a < 8; ++a) {
        const int kr = rs + a;
        const LAS float* rlrow = rl + (kr - r + 7) * 32;
        ATT_LOAD(kB, vB, kl + (size_t)(kr * 64 + 32) * 512, vtl + kr * 64 + 32, 16 * 4096);
        __builtin_amdgcn_sched_barrier(0);
#pragma unroll
        for (int qb = 0; qb < 3; ++qb) attn_group(st[qb], kA, vA, qs[(qb * 2 + 0) * 64], qs[(qb * 2 + 1) * 64], 0, 16 * qb + qi, rlrow, g);
        { const bool more = a < 7;
          const bf16_t* kpn = more ? kl + (size_t)((kr + 1) * 64) * 512 : kc; const bf16_t* vpn = more ? vtl + (kr + 1) * 64 : vtc; const int vsn = more ? 16 * 4096 : 16 * 256;
          ATT_LOAD(kA, vA, kpn, vpn, vsn); }
        __builtin_amdgcn_sched_barrier(0);
#pragma unroll
        for (int qb = 1; qb < 4; ++qb) attn_group(st[qb], kB, vB, qs[(qb * 2 + 0) * 64], qs[(qb * 2 + 1) * 64], 32, 16 * qb + qi, rlrow, g);
    }
    for (int cgp = 0; cgp < 8; cgp += 2) {
        ATT_LOAD(kB, vB, kc + (size_t)(32 * (cgp + 1)) * 512, vtc + 32 * (cgp + 1), 16 * 256);
        __builtin_amdgcn_sched_barrier(0);
#pragma unroll
        for (int qb = 0; qb < 4; ++qb) attn_group(st[qb], kA, vA, qs[(qb * 2 + 0) * 64], qs[(qb * 2 + 1) * 64], -1, 0, rl, g);
        if (cgp + 2 < 8) ATT_LOAD(kA, vA, kc + (size_t)(32 * (cgp + 2)) * 512, vtc + 32 * (cgp + 2), 16 * 256);
        __builtin_amdgcn_sched_barrier(0);
#pragma unroll
        for (int qb = 0; qb < 4; ++qb) attn_group(st[qb], kB, vB, qs[(qb * 2 + 0) * 64], qs[(qb * 2 + 1) * 64], -1, 0, rl, g);
    }
#undef ATT_LOAD
#pragma unroll
    for (int qb = 0; qb < 4; ++qb) {
        float l = st[qb].l; l += __shfl_xor(l, 16); l += __shfl_xor(l, 32);
        const float inv = 1.0f / l;
        const size_t tq = (size_t)b * SEQ + r * 64 + 16 * qb + qi;
#pragma unroll
        for (int dt = 0; dt < 4; ++dt) { const f32x4 o = st[qb].o[dt] * inv; u32x2 w; w.x = cvt_pk_bf16(o[0], o[1]); w.y = cvt_pk_bf16(o[2], o[3]);
            PL8(MIX + tq * D + 512 + h * 64 + dt * 16 + 4 * g, w); }
    }
}

__device__ __forceinline__ void conv_phase(const Params& p, const bf16_t* YG, bf16_t* MIX, LAS unsigned char* lds, unsigned* counter) {
    constexpr int TT = 32, NIT = NTOK / TT;
    const int tid = threadIdx.x, lane = tid & 63, wave = tid >> 6, c = tid;
    LAS float* red = (LAS float*)lds;
    LAS float* stat = (LAS float*)(lds + TT * 2048);
    float w[31];
#pragma unroll
    for (int j = 0; j < 31; ++j) w[j] = p.in[I_CONVW][j * 512 + c];
    const float cb = p.in[I_CONVB][c], lg = p.in[I_CONVLNG][c], lb = p.in[I_CONVLNB][c];
    LAS int* qslot = (LAS int*)(lds + TT * 2048 + 1024);
    for (;;) {
        if (tid == 0) *qslot = (int)atomicAdd(counter, 1u);
        __syncthreads();
        const int item = *qslot;
        if (item >= NIT) break;
        const int t0 = item * TT, b = t0 >> 12, n0 = t0 & 4095;
        float in[TT + 30];
#pragma unroll
        for (int i = 0; i < TT + 30; ++i) { const int n = n0 - 15 + i; in[i] = (n >= 0 && n < SEQ) ? bf2f(YG[((size_t)b * SEQ + n) * 512 + c]) : 0.f; }
        float y[TT];
#pragma unroll
        for (int t = 0; t < TT; ++t) { float a = cb;
#pragma unroll
            for (int j = 0; j < 31; ++j) a += in[t + j] * w[j];
            y[t] = a; }
#pragma unroll
        for (int t = 0; t < TT; ++t) red[t * 512 + c] = y[t];
        __syncthreads();
#pragma unroll
        for (int tt = 0; tt < TT / 8; ++tt) { const int t = (TT / 8) * wave + tt; float s = 0.f;
#pragma unroll
            for (int i = 0; i < 8; ++i) s += red[t * 512 + lane + 64 * i];
            s = wave_sum(s); if (lane == 0) stat[t] = s * (1.0f / 512.0f); }
        __syncthreads();
#pragma unroll
        for (int t = 0; t < TT; ++t) { y[t] -= stat[t]; red[t * 512 + c] = y[t] * y[t]; }
        __syncthreads();
#pragma unroll
        for (int tt = 0; tt < TT / 8; ++tt) { const int t = (TT / 8) * wave + tt; float s = 0.f;
#pragma unroll
            for (int i = 0; i < 8; ++i) s += red[t * 512 + lane + 64 * i];
            s = wave_sum(s); if (lane == 0) stat[TT + t] = rsqrtf(s * (1.0f / 512.0f) + 1e-6f); }
        __syncthreads();
#pragma unroll
        for (int t = 0; t < TT; ++t) { const float z = y[t] * stat[TT + t] * lg + lb; const unsigned pk = cvt_pk_bf16(siluf_(z), 0.f);
            PL2(MIX + (size_t)(t0 + t) * D + c, pk & 0xffffu); }
        __syncthreads();
    }
}

__global__ void __launch_bounds__(512, 2) mega(Params p) {
    extern __shared__ __attribute__((aligned(16))) unsigned char lds_raw[];
    LAS unsigned char* lds = (LAS unsigned char*)lds_raw;
    cg::grid_group grid = cg::this_grid();
    const int G = gridDim.x, c = blockIdx.x;
    volatile LAS unsigned* bst = (volatile LAS unsigned*)(lds + 131072 + 64);
    if (threadIdx.x < 2) bst[threadIdx.x] = 0u;
    __syncthreads();
    const XcdBarrier xbar = xcd_barrier_post((unsigned*)(p.ws + WS_BAR), bst);
    if (G > (1 << 20)) grid.sync();
#define GSYNC() xcd_barrier(xbar)
    const int vcu = (G % 8 == 0) ? (c % 8) * (G / 8) + c / 8 : c;
    unsigned char* ws = p.ws;
    float* MOD = (float*)(ws + WS_MOD);
    float* HC = (float*)(ws + WS_HC);
    bf16_t* XN = (bf16_t*)(ws + WS_XN);
    bf16_t* ACT = (bf16_t*)(ws + WS_ACT);
    bf16_t* MIX = (bf16_t*)(ws + WS_MIX); bf16_t* F = (bf16_t*)(ws + WS_F);
    bf16_t *YG = (bf16_t*)(ws + WS_YG), *QB = (bf16_t*)(ws + WS_QB), *KB = (bf16_t*)(ws + WS_KB), *VTL = (bf16_t*)(ws + WS_VTL), *VTC = (bf16_t*)(ws + WS_VTC);
    bf16_t* T = (bf16_t*)(ws + WS_T);

    prologue(p, lds);
    GSYNC();

    float* SS = (float*)(ws + WS_SS);
    const float* NG = p.in[I_NORMG];
    const float* MOD1 = MOD + (size_t)5 * 9216;

    prenorm_rows(p.in[I_X], p.in[I_CTX], 0, MT, NG, MOD + 1 * 1024, SS, XN);
    cb_tables(p);
    GSYNC();

#define FFN_SUBLAYER(inst, nrows, SRC0, SRC1, LASTSUB)                                                                                                 \
    {                                                                                                                                                  \
        constexpr int layer_ = (inst) / 3, sub_ = ((inst) % 3) ? 1 : 0, mi_ = layer_ * 2 + sub_, nx_ = (inst) + 1;                                     \
        const float* mod_l = MOD + (size_t)layer_ * 5 * 9216;                                                                                          \
        { pg8::Gemm g{D, D, D}; PlainOrder S{(const char*)XN, (const char*)(ws + WS_W1T + mi_ * SZ_W1T), (size_t)256 * D * 2, (size_t)256 * D * 2, (nrows) / 256, NFF1 / 256, G, c}; \
          EpiSwiglu E{ws, (inst) * MT, mi_ * 5 * NFF1}; pg8::gemm_phase(lds, g, S, E); }                     \
        GSYNC();                                                                                                                                       \
        { pg8::Gemm g{DFF, DFF, DFF}; PlainOrder S{(const char*)ACT, (const char*)(ws + WS_W2T + mi_ * SZ_W2T), (size_t)256 * DFF * 2, (size_t)256 * DFF * 2, NTOK / 256, D / 256, G, c}; \
          EpiResid<!(LASTSUB), (inst) != 0, false> E{ws, (SRC0), (SRC1), nullptr, 0.5f, layer_ * 5 * 9216 + (sub_ ? 8 : 2) * 1024, nx_ * MT, nx_ * D, (nx_ / 3) * 5 * 9216 + (3 * (nx_ % 3) + 1) * 1024};              \
          pg8::gemm_phase(lds, g, S, E); }                                                                                                             \
        if ((nrows) > NTOK) { pg8::Gemm g{DFF, DFF, 256}; CtxSplitOrder S{(const char*)ACT, (const char*)(ws + WS_W2T), G, c}; EpiCtxAtomic E{HC, mod_l + 4 * 9216 + 2 * 1024, 0.5f}; pg8::gemm_phase(lds, g, S, E); } \
        GSYNC();                                                                                                                                       \
    }

    FFN_SUBLAYER(0, MT, p.in[I_X], p.in[I_CTX] - (size_t)NTOK * D, false);
    prenorm_rows(nullptr, HC, NTOK, MT, NG + 1 * D, MOD + 4 * 1024, SS + (size_t)1 * MT, XN);
    gen_dftl(ws, lds, 128);
    { pg8::Gemm g{D, D, D}; MixInOrder S{(const char*)XN, (const char*)(ws + WS_WABT), G, c, 0, 640}; EpiMixIn E{ws, 1 * MT}; pg8::gemm_phase(lds, g, S, E); }
    GSYNC();
    { pg8::Gemm g{D, D, D}; MixInOrder S{(const char*)XN, (const char*)(ws + WS_WABT), G, c, 640, 656}; EpiMixIn E{ws, 1 * MT}; pg8::gemm_phase(lds, g, S, E); }
    conv_phase(p, YG, MIX, lds, (unsigned*)(ws + WS_BAR) + CNT_WORD);
    GSYNC();
    {
        const int wave = threadIdx.x >> 6, lane = threadIdx.x & 63;
        LAS float* rl = (LAS float*)(lds + 40960 + wave * 10240);
        for (int u = c * 8 + wave; u < 2048; u += G * 8) attn_unit(u, QB, KB, VTL, VTC, p.in[I_RPB], MIX, rl, lane);
    }
    GSYNC();
    { pg8::Gemm g{D, D, D}; PlainOrder S{(const char*)MIX, (const char*)(ws + WS_WOT), (size_t)256 * D * 2, (size_t)256 * D * 2, NTOK / 256, D / 256, G, c};
      EpiResid<true, true, false> E{ws, nullptr, nullptr, nullptr, 1.0f, 5 * 1024, 2 * MT, 2 * D, 7 * 1024}; pg8::gemm_phase(lds, g, S, E); }
    GSYNC();
    FFN_SUBLAYER(2, NTOK, nullptr, nullptr, false);

    FFN_SUBLAYER(3, NTOK, nullptr, nullptr, false);
    { pg8::Gemm g{256, D, 256}; DftAOrder S{(const char*)(ws + WS_DFTC), (const char*)XN, G, vcu}; EpiDftA E{ws, 4 * MT}; pg8::gemm_phase(lds, g, S, E); }
    GSYNC();
    { pg8::Gemm g{8192, 8192, 4096}; DftBOrder S{(const char*)(ws + WS_DFTL), (const char*)T, G, vcu}; EpiDftX E{ws}; pg8::gemm_phase(lds, g, S, E); }
    GSYNC();
    { pg8::Gemm g{D, D, D}; PlainOrder S{(const char*)F, (const char*)(ws + WS_WFT), (size_t)256 * D * 2, (size_t)256 * D * 2, NTOK / 256, D / 256, G, c};
      EpiResid<true, true, true> E{ws, nullptr, nullptr, p.in[I_FNETB], 1.0f, 5 * 9216 + 5 * 1024, 5 * MT, 5 * D, 5 * 9216 + 7 * 1024}; pg8::gemm_phase(lds, g, S, E); }
    GSYNC();
    { pg8::Gemm g{D, D, D}; PlainOrder S{(const char*)XN, (const char*)(ws + WS_W1T + 3 * SZ_W1T), (size_t)256 * D * 2, (size_t)256 * D * 2, NTOK / 256, NFF1 / 256, G, c};
      EpiSwiglu E{ws, 5 * MT, 3 * 5 * NFF1}; pg8::gemm_phase(lds, g, S, E); }
    GSYNC();
    { pg8::Gemm g{DFF, DFF, DFF}; PlainOrder S{(const char*)ACT, (const char*)(ws + WS_W2T + 3 * SZ_W2T), (size_t)256 * DFF * 2, (size_t)256 * DFF * 2, NTOK / 256, D / 256, G, c};
      EpiFinal E{ws, p.out, p.in[I_FINALG], 5 * 9216 + 8 * 1024}; pg8::gemm_phase(lds, g, S, E); }
}

extern "C" void kernel_launch(void* const* d_in, const int* in_sizes, int n_in, void* d_out, int out_size, void* d_ws, size_t ws_size, hipStream_t stream) {
    static int grid = 0;
    if (grid == 0) {
        int dev = 0, cus = 0, per_cu = 0;
        (void)hipGetDevice(&dev);
        (void)hipDeviceGetAttribute(&cus, hipDeviceAttributeMultiprocessorCount, dev);
        (void)hipFuncSetAttribute((const void*)mega, hipFuncAttributeMaxDynamicSharedMemorySize, LDS_BYTES);
        (void)hipOccupancyMaxActiveBlocksPerMultiprocessor(&per_cu, (const void*)mega, 512, LDS_BYTES);
        fprintf(stderr, "kernel_launch: cus %d per_cu %d ws %zu need %zu\n", cus, per_cu, ws_size, (size_t)WS_TOTAL);
        if (n_in != 19 || ws_size < WS_TOTAL || per_cu < 1) { fprintf(stderr, "kernel_launch: unexpected configuration; nothing launched\n"); grid = -1; return; }
        grid = cus;
    }
    if (grid < 0) return;
    Params p{};
    for (int i = 0; i < 19; ++i) p.in[i] = (const float*)d_in[i];
    p.out = (float*)d_out; p.ws = (unsigned char*)d_ws;
    (void)hipMemsetAsync((char*)d_ws + WS_BAR, 0, 16384, stream);
    void* args[] = {&p};
    hipError_t e = hipLaunchCooperativeKernel((const void*)mega, dim3(grid), dim3(512), args, LDS_BYTES, stream);
    if (e != hipSuccess) fprintf(stderr, "cooperative launch failed: %s (grid %d)\n", hipGetErrorString(e), grid);
}
```

```cpp
#include <hip/hip_runtime.h>
#include <hip/hip_cooperative_groups.h>
#include <cstdio>
#include <cstdint>
namespace cg = cooperative_groups;

#define LAS __attribute__((address_space(3)))
typedef unsigned short bf16_t;
typedef short bf16x8 __attribute__((ext_vector_type(8)));
typedef float f32x4 __attribute__((ext_vector_type(4)));
typedef unsigned u32x4 __attribute__((ext_vector_type(4)));
typedef unsigned u32x2 __attribute__((ext_vector_type(2)));

constexpr int D = 1024, SEQ = 4096, NTOK = 16384, NCTX = 1024, MT = NTOK + NCTX, DFF = 2816, NFF1 = 2 * DFF, NAB = 2560;
constexpr int LDS_BYTES = 147456;

constexpr size_t WS_MOD = 0;
constexpr size_t WS_NG = 360u << 10;
constexpr size_t WS_BAR = 384u << 10;
constexpr int    CNT_WORD = 3584;
constexpr size_t WS_SS = 400u << 10;
constexpr size_t WS_SSF = 816u << 10;
constexpr size_t WS_CNTF = 880u << 10;
constexpr size_t WS_CNTX = 896u << 10;
constexpr size_t WS_CB = 1u << 20;
constexpr size_t WS_CBAB = WS_CB + (size_t)4 * 5 * 5632 * 4;
constexpr size_t WS_CBD = WS_CBAB + (size_t)5 * 2560 * 4;
static_assert(WS_SS + (size_t)6 * 17408 * 4 <= WS_CB && WS_CBD + 5 * 2048 * 4 <= (2u << 20), "small tables fit");
constexpr size_t WS_W1T = 2u << 20;
constexpr size_t SZ_W1T = (size_t)NFF1 * D * 2;
constexpr size_t WS_W2T = WS_W1T + 4 * SZ_W1T;
constexpr size_t SZ_W2T = (size_t)D * DFF * 2;
constexpr size_t WS_WABT = WS_W2T + 4 * SZ_W2T;
constexpr size_t WS_WOT = WS_WABT + (size_t)NAB * D * 2;
constexpr size_t WS_WFT = WS_WOT + (size_t)D * D * 2;
constexpr size_t WS_DFTC = WS_WFT + (size_t)D * D * 2;
constexpr size_t WS_DFTL = WS_DFTC + 512 * 256 * 2;
constexpr size_t WS_H = WS_DFTL + (size_t)4096 * 8192 * 2;
constexpr size_t WS_HC = WS_H + (size_t)NTOK * D * 2;
constexpr size_t WS_XN = WS_HC + (size_t)NCTX * D * 4;
constexpr size_t WS_ACT = WS_XN + (size_t)MT * D * 2;
constexpr size_t WS_END = WS_ACT + (size_t)MT * DFF * 2;
constexpr size_t WS_YG = WS_ACT;
constexpr size_t WS_QB = WS_YG + (size_t)NTOK * 512 * 2;
constexpr size_t WS_KB = WS_QB + (size_t)NTOK * 512 * 2;
constexpr size_t WS_VTL = WS_KB + (size_t)MT * 512 * 2;
constexpr size_t WS_VTC = WS_VTL + (size_t)NTOK * 512 * 2;
static_assert(WS_VTC + (size_t)NCTX * 512 * 2 <= WS_END, "mixer aliases fit");
constexpr size_t WS_MIX = WS_VTC + (size_t)NCTX * 512 * 2;
constexpr size_t WS_T = WS_ACT;
constexpr size_t WS_F = WS_T + (size_t)16 * 256 * 8192 * 2;
constexpr size_t WS_TOTAL = (WS_MIX + (size_t)NTOK * D * 2) > (WS_F + (size_t)NTOK * D * 2) ? (WS_MIX + (size_t)NTOK * D * 2) : (WS_F + (size_t)NTOK * D * 2);

__device__ __forceinline__ float wave_sum(float v) {
#pragma unroll
    for (int o = 1; o < 64; o <<= 1) v += __shfl_xor(v, o);
    return v;
}
__device__ __forceinline__ unsigned cvt_pk_bf16(float lo, float hi) { unsigned r; asm volatile("v_cvt_pk_bf16_f32 %0, %1, %2" : "=v"(r) : "v"(lo), "v"(hi)); return r; }
#define NT16(p, v) __builtin_nontemporal_store((v), (u32x4*)(p))
#define PL16(p, v) (*(u32x4*)(p) = (v))
#define PL8(p, v) (*(u32x2*)(p) = (v))
#define PL2(p, v) (*(bf16_t*)(p) = (bf16_t)(v))
#ifndef NTG
#define NTG 1
#endif
#define ST16(grp, p, v) do { if ((NTG >> (grp)) & 1) NT16(p, v); else PL16(p, v); } while (0)
__device__ __forceinline__ float bf2f(unsigned short b) { return __uint_as_float(((unsigned)b) << 16); }
__device__ __forceinline__ float fast_exp(float x) { return __builtin_amdgcn_exp2f(x * 1.44269504089f); }
__device__ __forceinline__ float sigmoidf_(float x) { return __builtin_amdgcn_rcpf(1.0f + fast_exp(-x)); }
__device__ __forceinline__ float siluf_(float x) { return x * sigmoidf_(x); }


#define XB_TMO      128
#define XB_XCNT(j)  (256  + 64 * (j))
#define XB_XSUB(j)  (1280 + 64 * (j))
#define XB_XGEN(j)  (2304 + 64 * (j))
#define XB_TOP      3328
#define XB_TOPGEN   3392
#define XCD_BAR_WORDS 3456
#define XB_SPIN_CAP (1u << 18)
__device__ __forceinline__ unsigned xb_ld(unsigned* p)              { return __hip_atomic_load(p, __ATOMIC_RELAXED, __HIP_MEMORY_SCOPE_AGENT); }
__device__ __forceinline__ unsigned xb_add(unsigned* p, unsigned v) { return __hip_atomic_fetch_add(p, v, __ATOMIC_RELAXED, __HIP_MEMORY_SCOPE_AGENT); }
__device__ __forceinline__ unsigned xb_xcc_id() { return (unsigned)__builtin_amdgcn_s_getreg((3 << 11) | 20) & 0xFu; }
#ifndef XB_SLEEP
#define XB_SLEEP 1
#endif
#define XB_SPIN(cond, bar) do { unsigned _sp = 0; while (cond) { if (XB_SLEEP) __builtin_amdgcn_s_sleep(1); \
    if ((++_sp & 255u) == 0u) { if (xb_ld(&(bar)[XB_TMO])) break; if (_sp > XB_SPIN_CAP) { atomicAdd(&(bar)[XB_TMO], 1u); break; } } } } while (0)
struct XcdBarrier { unsigned* bar; unsigned x; volatile LAS unsigned* st; };
__device__ __forceinline__ XcdBarrier xcd_barrier_post(unsigned* bar, volatile LAS unsigned* st) {
    XcdBarrier b; b.bar = bar; b.x = xb_xcc_id(); b.st = st;
    if (threadIdx.x == 0) (void)xb_add(&bar[XB_XCNT(b.x)], 1u);
    return b;
}
__device__ __forceinline__ void xcd_barrier_complete(unsigned* bar, unsigned x, unsigned& nloc, unsigned& nx) {
    const unsigned G = gridDim.x * gridDim.y * gridDim.z;
    unsigned sum, cnt, mine, sp = 0u;
    for (;;) {
        sum = 0u; cnt = 0u; mine = 0u;
#pragma unroll
        for (unsigned j = 0; j < 16; ++j) { const unsigned c = xb_ld(&bar[XB_XCNT(j)]); sum += c; cnt += (c > 0u) ? 1u : 0u; mine = (j == x) ? c : mine; }
        if (sum == G) break;
        __builtin_amdgcn_s_sleep(1);
        if ((++sp & 255u) == 0u) { if (xb_ld(&bar[XB_TMO])) break; if (sp > XB_SPIN_CAP) { atomicAdd(&bar[XB_TMO], 1u); break; } }
    }
    nloc = mine > 0u ? mine : 1u; nx = cnt > 0u ? cnt : 1u;
}
__device__ __forceinline__ void xcd_barrier(const XcdBarrier& b) {
    asm volatile("s_waitcnt vmcnt(0)" ::: "memory");
    __syncthreads();
    if (threadIdx.x == 0) {
        unsigned* bar = b.bar;
        __builtin_amdgcn_s_waitcnt(0);
        unsigned nloc = b.st[0], nx = b.st[1];
        if (nloc == 0u) { xcd_barrier_complete(bar, b.x, nloc, nx); b.st[0] = nloc; b.st[1] = nx; }
        const unsigned old = xb_add(&bar[XB_XSUB(b.x)], 1u);
        const unsigned gen = old / nloc;
        if (old + 1u == (gen + 1u) * nloc) {
            __builtin_amdgcn_fence(__ATOMIC_RELEASE, "agent");
            asm volatile("s_waitcnt vmcnt(0)" ::: "memory");
            const unsigned og = xb_add(&bar[XB_TOP], 1u);
            const unsigned tg = og / nx;
            if (og + 1u == (tg + 1u) * nx) xb_add(&bar[XB_TOPGEN], 1u);
            else XB_SPIN(xb_ld(&bar[XB_TOPGEN]) == tg, bar);
            __builtin_amdgcn_fence(__ATOMIC_ACQUIRE, "agent");
            xb_add(&bar[XB_XGEN(b.x)], 1u);
            asm volatile("s_waitcnt vmcnt(0)" ::: "memory");
        } else {
            XB_SPIN(xb_ld(&bar[XB_XGEN(b.x)]) == gen, bar);
            __builtin_amdgcn_fence(__ATOMIC_ACQUIRE, "agent");
            asm volatile("s_waitcnt vmcnt(0)" ::: "memory");
        }
    }
    __syncthreads();
}

namespace pg8 {
constexpr int BM = 256, BK = 64, HALF = 128, HTB = HALF * BK * 2, STAGE_BYTES = 8 * HTB, NXCD = 8, WGM = 8;
__host__ __device__ __forceinline__ int lds_byte(int r, int c) { const int st = (r >> 4) * 2 + (c >> 5), rr = r & 15, cc = c & 31, ob = rr * 64 + cc * 2; return st * 1024 + (ob ^ (((ob >> 9) & 1) << 5)); }
__host__ __device__ __forceinline__ void stage_rc(int b, int& R, int& C) { const int st = b / 1024, sb = b % 1024, swz = sb ^ (((sb >> 9) & 1) << 5); R = (st >> 1) * 16 + swz / 64; C = (st & 1) * 32 + (swz % 64) / 2; }
__host__ __device__ __forceinline__ int perm32(int rho) { const int n = rho >> 4, i = rho & 15; return 8 * (i >> 2) + 4 * n + (i & 3); }

struct Unit { const char* A; const char* B; int pm, pn, z; };
struct Gemm { int lda, ldb, K; };

__device__ __forceinline__ void static_map(int L, int nM, int nN, int& pm, int& pn) {
    const int nwg = nM * nN; int wgid = L;
    { const int q = nwg / NXCD, r = nwg % NXCD, xcd = wgid % NXCD, off = wgid / NXCD; wgid = (xcd < r ? xcd * (q + 1) : r * (q + 1) + (xcd - r) * q) + off; }
    const int nig = WGM * nN, gid = wgid / nig, fm = gid * WGM, gsz = (nM - fm) < WGM ? (nM - fm) : WGM;
    pm = fm + ((wgid % nig) % gsz); pn = (wgid % nig) / gsz;
}

template <class Epi, class Sched>
__device__ __forceinline__ void gemm_phase(LAS unsigned char* lds, const Gemm g, const Sched& S, const Epi& E) {
#ifndef PG8_ALIGN
#define PG8_ALIGN true
#endif
    constexpr bool ALIGN_EPI = PG8_ALIGN;
    int tid = threadIdx.x; asm volatile("" : "+v"(tid));
    const int wid = __builtin_amdgcn_readfirstlane(tid >> 6), lane = tid & 63, wr = wid >> 2, wc = wid & 3, fr = lane & 15, fq = lane >> 4;
    int K = g.K; asm volatile("" : "+s"(K));
    const int nt = K / BK;
    unsigned voffA[2], voffB[2];
#pragma unroll
    for (int i = 0; i < 2; ++i) { int R, C; stage_rc(tid * 16 + i * 8192, R, C); const int Rb = Epi::PERM ? ((R & ~31) + perm32(R & 31)) : R;
        voffA[i] = (unsigned)(R * g.lda + C) * 2u; voffB[i] = (unsigned)(Rb * g.ldb + C) * 2u; }
    const size_t kstep = (size_t)(BK * 2);
    const size_t hstepA = (size_t)HALF * g.lda * 2, hstepB = (size_t)HALF * g.ldb * 2;
    const unsigned ldsw = (unsigned)wid * 1024u;
    const int aoff = lds_byte(wr * 64 + fr, fq * 8), boff = lds_byte(wc * 32 + fr, fq * 8);
#define PG8_SA(b, h) (((b) * 2 + (h)) * HTB)
#define PG8_SB(b, h) ((4 + (b) * 2 + (h)) * HTB)
#define PG8_STAGE(bufoff, gbase, voff) do { _Pragma("unroll") for (int _i = 0; _i < 2; ++_i) \
        __builtin_amdgcn_global_load_lds((const unsigned*)((const char*)(gbase) + (voff)[_i]), (LAS unsigned*)(lds + (bufoff) + ldsw + _i * 8192), 16, 0, 0); } while (0)
#define PG8_LDA(dst, b, h) do { _Pragma("unroll") for (int m = 0; m < 4; ++m) _Pragma("unroll") for (int k = 0; k < 2; ++k) dst[m][k] = *(const LAS bf16x8*)(lds + PG8_SA(b, h) + aoff + m * 2048 + k * 1024); } while (0)
#define PG8_LDB(dst, b, h) do { _Pragma("unroll") for (int n = 0; n < 2; ++n) _Pragma("unroll") for (int k = 0; k < 2; ++k) dst[n][k] = *(const LAS bf16x8*)(lds + PG8_SB(b, h) + boff + n * 2048 + k * 1024); } while (0)
#define PG8_MMA(ai, bj, At, Bt) do { __builtin_amdgcn_s_setprio(1); _Pragma("unroll") for (int m = 0; m < 4; ++m) _Pragma("unroll") for (int n = 0; n < 2; ++n) _Pragma("unroll") for (int k = 0; k < 2; ++k) \
        acc[ai][bj][m][n] = __builtin_amdgcn_mfma_f32_16x16x32_bf16(Bt[n][k], At[m][k], acc[ai][bj][m][n], 0, 0, 0); __builtin_amdgcn_s_setprio(0); } while (0)
#define PG8_WAIT_V(n) asm volatile("s_waitcnt vmcnt(" #n ")" ::: "memory")
#define PG8_WAIT_L(n) asm volatile("s_waitcnt lgkmcnt(" #n ")" ::: "memory")
#define PG8_BAR __builtin_amdgcn_s_barrier()
#define PG8_SCHED __builtin_amdgcn_sched_barrier(0)
    Unit cur, nxt; int ui = 0;
    if (!S.next(0, cur)) return;
    f32x4 acc[2][2][4][2];
#pragma unroll
    for (int a = 0; a < 2; ++a)
#pragma unroll
        for (int b = 0; b < 2; ++b)
#pragma unroll
            for (int m = 0; m < 4; ++m)
#pragma unroll
                for (int n = 0; n < 2; ++n) acc[a][b][m][n] = (f32x4){0.f, 0.f, 0.f, 0.f};
    bf16x8 At[4][2], B0[2][2], B1[2][2];
    const char* cA = cur.A; const char* cB = cur.B;
    PG8_STAGE(PG8_SB(0, 0), cB, voffB); PG8_STAGE(PG8_SB(0, 1), cB + hstepB, voffB); PG8_STAGE(PG8_SA(0, 0), cA, voffA); PG8_STAGE(PG8_SA(0, 1), cA + hstepA, voffA);
    if (wr == 1) PG8_BAR;
    PG8_WAIT_V(2); PG8_BAR;
    PG8_STAGE(PG8_SB(1, 0), cB + kstep, voffB); PG8_STAGE(PG8_SA(1, 0), cA + kstep, voffA); PG8_STAGE(PG8_SB(1, 1), cB + hstepB + kstep, voffB);
    PG8_WAIT_V(6); PG8_BAR;
    for (;;) {
        const bool has_next = S.next(ui + 1, nxt);
        const char* nA = has_next ? nxt.A : cA; const char* nB = has_next ? nxt.B : cB;
        for (int t = 0; t < nt; t += 2) {
            const bool last = (t == nt - 2);
            const char* a1 = cA + (size_t)(t + 1) * kstep;
            const char* a2 = last ? nA : cA + (size_t)(t + 2) * kstep; const char* b2 = last ? nB : cB + (size_t)(t + 2) * kstep;
            const char* a3 = a2 + kstep; const char* b3 = b2 + kstep;
            PG8_LDB(B0, 0, 0); PG8_LDB(B1, 0, 1); PG8_SCHED; PG8_LDA(At, 0, 0); PG8_STAGE(PG8_SA(1, 1), a1 + hstepA, voffA);
            PG8_WAIT_V(8); PG8_WAIT_L(0); PG8_BAR; PG8_MMA(0, 0, At, B0); PG8_MMA(0, 1, At, B1); PG8_BAR; PG8_SCHED;
            PG8_LDA(At, 0, 1); PG8_STAGE(PG8_SB(0, 0), b2, voffB); PG8_STAGE(PG8_SB(0, 1), b2 + hstepB, voffB); PG8_STAGE(PG8_SA(0, 0), a2, voffA);
            PG8_WAIT_V(8); PG8_WAIT_L(0); PG8_BAR; PG8_MMA(1, 0, At, B0); PG8_MMA(1, 1, At, B1); PG8_BAR; PG8_SCHED;
            PG8_LDB(B0, 1, 0); PG8_LDB(B1, 1, 1); PG8_SCHED; PG8_LDA(At, 1, 0); PG8_STAGE(PG8_SA(0, 1), a2 + hstepA, voffA);
            PG8_WAIT_V(8); PG8_WAIT_L(0); PG8_BAR; PG8_MMA(0, 0, At, B0); PG8_MMA(0, 1, At, B1); PG8_BAR; PG8_SCHED;
            PG8_LDA(At, 1, 1); PG8_STAGE(PG8_SB(1, 0), b3, voffB); PG8_STAGE(PG8_SB(1, 1), b3 + hstepB, voffB); PG8_STAGE(PG8_SA(1, 0), a3, voffA);
            PG8_WAIT_V(8); PG8_WAIT_L(0); PG8_BAR; PG8_MMA(1, 0, At, B0); PG8_MMA(1, 1, At, B1); PG8_BAR; PG8_SCHED;
        }
        if constexpr (ALIGN_EPI) { if (wr == 0) PG8_BAR; }
        if constexpr (!Epi::AFTER_DRAIN) E(acc, cur, wr, wc, fr, fq);
        if (!has_next) break;
#pragma unroll
        for (int a = 0; a < 2; ++a)
#pragma unroll
            for (int b = 0; b < 2; ++b)
#pragma unroll
                for (int m = 0; m < 4; ++m)
#pragma unroll
                    for (int n = 0; n < 2; ++n) acc[a][b][m][n] = (f32x4){0.f, 0.f, 0.f, 0.f};
        cur = nxt; cA = nA; cB = nB; ++ui;
        if constexpr (ALIGN_EPI) { if (wr == 1) PG8_BAR; }
    }
    PG8_WAIT_V(0);
    if constexpr (!ALIGN_EPI) { if (wr == 0) PG8_BAR; }
    PG8_BAR;
    if constexpr (Epi::AFTER_DRAIN) E.fused(acc, cur, wr, wc, fr, fq);
#undef PG8_SA
#undef PG8_SB
#undef PG8_STAGE
#undef PG8_LDA
#undef PG8_LDB
#undef PG8_MMA
#undef PG8_WAIT_V
#undef PG8_WAIT_L
#undef PG8_BAR
#undef PG8_SCHED
}
}
using pg8::Unit;

struct PlainOrder {
    const char* A; const char* B; size_t tA, tB; int nM, nN, G, c;
    __device__ __forceinline__ bool next(int i, Unit& u) const {
        const int L = i * G + c; if (L >= nM * nN) return false;
        int pm, pn; pg8::static_map(L, nM, nN, pm, pn);
        u.pm = pm; u.pn = pn; u.z = 0; u.A = A + (size_t)pm * tA; u.B = B + (size_t)pn * tB; return true;
    }
};
struct MixInOrder {
    const char* A; const char* B; int G, c, lo, hi;
    __device__ __forceinline__ bool next(int i, Unit& u) const {
        const int L = lo + i * G + c; if (L >= hi) return false;
        int pm, pn;
        if (L < 640) pg8::static_map(L, 64, 10, pm, pn); else { const int e = L - 640; pm = 64 + (e >> 2); pn = 6 + (e & 3); }
        u.pm = pm; u.pn = pn; u.z = 0; u.A = A + (size_t)pm * (256 * D * 2); u.B = B + (size_t)pn * (256 * D * 2); return true;
    }
};
struct CtxSplitOrder {
    const char* A; const char* B; int G, c;
    __device__ __forceinline__ bool next(int i, Unit& u) const {
        const int L = i * G + c; if (L >= 176) return false;
        const int t = L / 11, sp = L - t * 11, pm = t >> 2, pn = t & 3;
        u.pm = pm; u.pn = pn; u.z = sp; u.A = A + ((size_t)(NTOK + pm * 256) * DFF + sp * 256) * 2; u.B = B + ((size_t)(pn * 256) * DFF + sp * 256) * 2; return true;
    }
};
struct DftAOrder {
    const char* A; const char* XN; int G, v;
    __device__ __forceinline__ bool next(int i, Unit& u) const {
        const int L = i * G + v; if (L >= 512) return false;
        const int bg = L >> 5, rem = L & 31, pm = rem >> 4, pn = rem & 15, b = bg >> 2, gr = bg & 3;
        u.pm = pm; u.pn = pn; u.z = bg; u.A = A + (size_t)pm * (256 * 256 * 2); u.B = XN + ((size_t)(b * SEQ + pn * 256) * D + gr * 256) * 2; return true;
    }
};
struct DftBOrder {
    const char* A; const char* T; int G, v;
    __device__ __forceinline__ bool next(int i, Unit& u) const {
        const int L = i * G + v; if (L >= 256) return false;
        const int x = L >> 5, j = L & 31, pm = j & 7, rest = x * 4 + (j >> 3), which = rest & 1, bg = rest >> 1;
        u.pm = pm; u.pn = which; u.z = bg; u.A = A + (size_t)pm * (256 * (size_t)8192 * 2) + (size_t)which * 8192; u.B = T + (size_t)bg * (256 * (size_t)8192 * 2) + (size_t)which * 8192; return true;
    }
};

__device__ __forceinline__ float rstd_of(float ss) { return rsqrtf(ss * (1.0f / D) + 1e-6f); }
struct EpiSwiglu {
    static constexpr bool PERM = true; static constexpr bool AFTER_DRAIN = false;
    unsigned char* ws; int ss_off, cb_off;
    __device__ __forceinline__ void operator()(const f32x4 (&acc)[2][2][4][2], const Unit& u, int wr, int wc, int fr, int fq) const {
        const int row0 = u.pm * 256 + wr * 64 + fr, col0 = u.pn * 128 + wc * 32 + 8 * fq;
        const int mb = u.pm < 64 ? (u.pm >> 4) : 4;
        bf16_t* O = (bf16_t*)(ws + WS_ACT); const float* SSc = (const float*)(ws + WS_SS) + ss_off;
        const float* cbp = (const float*)(ws + WS_CB) + cb_off + (size_t)mb * NFF1 + u.pn * 256 + wc * 32 + 8 * fq;
        const f32x4 cg0 = *(const f32x4*)cbp, cg1 = *(const f32x4*)(cbp + 4), cu0 = *(const f32x4*)(cbp + 128), cu1 = *(const f32x4*)(cbp + 132);
        float rr[2][4];
#pragma unroll
        for (int ai = 0; ai < 2; ++ai)
#pragma unroll
            for (int m = 0; m < 4; ++m) rr[ai][m] = SSc[row0 + ai * 128 + m * 16];
#pragma unroll
        for (int ai = 0; ai < 2; ++ai)
#pragma unroll
            for (int m = 0; m < 4; ++m) {
                const int row = row0 + ai * 128 + m * 16;
                const float r = rstd_of(rr[ai][m]);
                bf16_t* rowp = O + (size_t)row * DFF + col0;
                const f32x4 g0 = acc[ai][0][m][0] * r + cg0, g1 = acc[ai][0][m][1] * r + cg1, u0 = acc[ai][1][m][0] * r + cu0, u1 = acc[ai][1][m][1] * r + cu1;
                u32x4 w;
                w.x = cvt_pk_bf16(siluf_(g0[0]) * u0[0], siluf_(g0[1]) * u0[1]); w.y = cvt_pk_bf16(siluf_(g0[2]) * u0[2], siluf_(g0[3]) * u0[3]);
                w.z = cvt_pk_bf16(siluf_(g1[0]) * u1[0], siluf_(g1[1]) * u1[1]); w.w = cvt_pk_bf16(siluf_(g1[2]) * u1[2], siluf_(g1[3]) * u1[3]);
                ST16(0, rowp, w);
            }
    }
};
template <bool FUSE, bool INPLACE, bool HASBIAS> struct EpiResid {
    static constexpr bool PERM = true; static constexpr bool AFTER_DRAIN = false;
    unsigned char* ws; const float* base0; const float* base1; const float* bias; float gmul; int gate_off, ss_off, gn_off, scn_off;
    __device__ __forceinline__ void operator()(const f32x4 (&acc)[2][2][4][2], const Unit& u, int wr, int wc, int fr, int fq) const {
        const int row0 = u.pm * 256 + wr * 64 + fr, col0 = u.pn * 256 + wc * 32 + 8 * fq;
        const int mb = u.pm < 64 ? (u.pm >> 4) : 4;
        float* SSn = (float*)(ws + WS_SS) + ss_off;
        const float* gate = (const float*)(ws + WS_MOD) + gate_off + (size_t)mb * 9216; const float* gn = (const float*)(ws + WS_NG) + gn_off; const float* scn = (const float*)(ws + WS_MOD) + scn_off + (size_t)mb * 9216;
        f32x4 gv[2][2], bv[2][2], wv[2][2];
#pragma unroll
        for (int bj = 0; bj < 2; ++bj)
#pragma unroll
            for (int n = 0; n < 2; ++n) { const int cc = col0 + bj * 128 + 4 * n;
                gv[bj][n] = *(const f32x4*)(gate + cc) * gmul;
                bv[bj][n] = HASBIAS ? *(const f32x4*)(bias + cc) : (f32x4){0.f, 0.f, 0.f, 0.f};
                wv[bj][n] = FUSE ? *(const f32x4*)(gn + cc) * (*(const f32x4*)(scn + cc) + 1.0f) : (f32x4){0.f, 0.f, 0.f, 0.f}; }
        const unsigned e0 = (unsigned)(row0 * D + col0);
        const char* bsc = (const char*)base0; char* Hc = (char*)(ws + WS_H); char* HBc = (char*)(ws + WS_XN);
        constexpr int RGB = 2;
#pragma unroll
        for (int rg = 0; rg < 8 / RGB; ++rg) {
            u32x4 braw[INPLACE ? RGB : 1][2]; f32x4 bb[INPLACE ? 1 : RGB][2][2];
#pragma unroll
            for (int mm = 0; mm < RGB; ++mm) { const int q = rg * RGB + mm, ai = q >> 2, m = q & 3;
#pragma unroll
                for (int bj = 0; bj < 2; ++bj) { const unsigned e = e0 + (unsigned)((ai * 128 + m * 16) * D + bj * 128);
                    if constexpr (INPLACE) braw[mm][bj] = *(const u32x4*)(Hc + (size_t)(e * 2u));
                    else { bb[mm][bj][0] = *(const f32x4*)(bsc + (size_t)(e * 4u)); bb[mm][bj][1] = *(const f32x4*)(bsc + (size_t)(e * 4u + 16u)); } } }
#pragma unroll
            for (int mm = 0; mm < RGB; ++mm) { const int q = rg * RGB + mm, ai = q >> 2, m = q & 3; float ssum = 0.f;
#pragma unroll
                for (int bj = 0; bj < 2; ++bj) { const unsigned e = e0 + (unsigned)((ai * 128 + m * 16) * D + bj * 128);
                    f32x4 r0, r1;
                    if constexpr (INPLACE) { const u32x4 q4 = braw[mm][bj];
                        r0 = (f32x4){__uint_as_float(q4[0] << 16), __uint_as_float(q4[0] & 0xffff0000u), __uint_as_float(q4[1] << 16), __uint_as_float(q4[1] & 0xffff0000u)};
                        r1 = (f32x4){__uint_as_float(q4[2] << 16), __uint_as_float(q4[2] & 0xffff0000u), __uint_as_float(q4[3] << 16), __uint_as_float(q4[3] & 0xffff0000u)}; }
                    else { r0 = bb[mm][bj][0]; r1 = bb[mm][bj][1]; }
                    const f32x4 h0 = r0 + gv[bj][0] * (acc[ai][bj][m][0] + bv[bj][0]), h1 = r1 + gv[bj][1] * (acc[ai][bj][m][1] + bv[bj][1]);
                    { u32x4 w; w.x = cvt_pk_bf16(h0[0], h0[1]); w.y = cvt_pk_bf16(h0[2], h0[3]); w.z = cvt_pk_bf16(h1[0], h1[1]); w.w = cvt_pk_bf16(h1[2], h1[3]); ST16(1, Hc + (size_t)(e * 2u), w); }
                    if (FUSE) { ssum += ((h0[0] * h0[0] + h0[1] * h0[1]) + (h0[2] * h0[2] + h0[3] * h0[3])) + ((h1[0] * h1[0] + h1[1] * h1[1]) + (h1[2] * h1[2] + h1[3] * h1[3]));
                        const f32x4 z0 = h0 * wv[bj][0], z1 = h1 * wv[bj][1];
                        u32x4 w; w.x = cvt_pk_bf16(z0[0], z0[1]); w.y = cvt_pk_bf16(z0[2], z0[3]); w.z = cvt_pk_bf16(z1[0], z1[1]); w.w = cvt_pk_bf16(z1[2], z1[3]);
                        ST16(2, HBc + (size_t)(e * 2u), w); } }
                if (FUSE) { ssum += __shfl_xor(ssum, 16); ssum += __shfl_xor(ssum, 32); if (fq == 0) unsafeAtomicAdd(SSn + (unsigned)(row0 + ai * 128 + m * 16), ssum); } }
            asm volatile("" ::: "memory"); }
    }
};
struct EpiFinal {
    static constexpr bool PERM = true; static constexpr bool AFTER_DRAIN = true;
    unsigned char* ws; float* out; const float* fg; int gate_off;
    __device__ __forceinline__ void fused(f32x4 (&acc)[2][2][4][2], const Unit& u, int wr, int wc, int fr, int fq) const {
        const int row0 = u.pm * 256 + wr * 64 + fr, col0 = u.pn * 256 + wc * 32 + 8 * fq;
        const int mb = u.pm >> 4;
        const char* Hc = (const char*)(ws + WS_H); float* SSF = (float*)(ws + WS_SSF); unsigned* cnt = (unsigned*)(ws + WS_CNTF) + 64 * u.pm;
        const float* gate = (const float*)(ws + WS_MOD) + gate_off + (size_t)mb * 9216;
        const unsigned e0 = (unsigned)(row0 * D + col0);
        {
            f32x4 gv[2][2];
#pragma unroll
            for (int bj = 0; bj < 2; ++bj)
#pragma unroll
                for (int n = 0; n < 2; ++n) gv[bj][n] = *(const f32x4*)(gate + col0 + bj * 128 + 4 * n) * 0.5f;
#pragma unroll
            for (int rg = 0; rg < 4; ++rg) {
                u32x4 braw[2][2];
#pragma unroll
                for (int mm = 0; mm < 2; ++mm) { const int q = rg * 2 + mm, ai = q >> 2, m = q & 3;
#pragma unroll
                    for (int bj = 0; bj < 2; ++bj) { const unsigned e = e0 + (unsigned)((ai * 128 + m * 16) * D + bj * 128); braw[mm][bj] = *(const u32x4*)(Hc + (size_t)(e * 2u)); } }
#pragma unroll
                for (int mm = 0; mm < 2; ++mm) { const int q = rg * 2 + mm, ai = q >> 2, m = q & 3; float ssum = 0.f;
#pragma unroll
                    for (int bj = 0; bj < 2; ++bj) { const u32x4 q4 = braw[mm][bj];
                        const f32x4 r0 = (f32x4){__uint_as_float(q4[0] << 16), __uint_as_float(q4[0] & 0xffff0000u), __uint_as_float(q4[1] << 16), __uint_as_float(q4[1] & 0xffff0000u)};
                        const f32x4 r1 = (f32x4){__uint_as_float(q4[2] << 16), __uint_as_float(q4[2] & 0xffff0000u), __uint_as_float(q4[3] << 16), __uint_as_float(q4[3] & 0xffff0000u)};
                        const f32x4 h0 = r0 + gv[bj][0] * acc[ai][bj][m][0], h1 = r1 + gv[bj][1] * acc[ai][bj][m][1]; acc[ai][bj][m][0] = h0; acc[ai][bj][m][1] = h1;
                        ssum += ((h0[0] * h0[0] + h0[1] * h0[1]) + (h0[2] * h0[2] + h0[3] * h0[3])) + ((h1[0] * h1[0] + h1[1] * h1[1]) + (h1[2] * h1[2] + h1[3] * h1[3])); }
                    ssum += __shfl_xor(ssum, 16); ssum += __shfl_xor(ssum, 32);
                    if (fq == 0) unsafeAtomicAdd(SSF + (unsigned)(row0 + ai * 128 + m * 16), ssum); }
                asm volatile("" ::: "memory"); }
        }
        asm volatile("s_waitcnt vmcnt(0)" ::: "memory");
        if ((threadIdx.x & 63) == 0) __hip_atomic_fetch_add(cnt, 1u, __ATOMIC_RELAXED, __HIP_MEMORY_SCOPE_AGENT);
        { unsigned spins = 0;
          while ((unsigned)__builtin_amdgcn_readfirstlane(__hip_atomic_load(cnt, __ATOMIC_RELAXED, __HIP_MEMORY_SCOPE_AGENT)) < 32u) { __builtin_amdgcn_s_sleep(2); if (++spins > (1u << 22)) break; } }
        float rr[2][4];
#pragma unroll
        for (int ai = 0; ai < 2; ++ai)
#pragma unroll
            for (int m = 0; m < 4; ++m) rr[ai][m] = rstd_of(__hip_atomic_load(SSF + (unsigned)(row0 + ai * 128 + m * 16), __ATOMIC_RELAXED, __HIP_MEMORY_SCOPE_AGENT));
        f32x4 fv[2][2];
#pragma unroll
        for (int bj = 0; bj < 2; ++bj)
#pragma unroll
            for (int n = 0; n < 2; ++n) fv[bj][n] = *(const f32x4*)(fg + col0 + bj * 128 + 4 * n);
#pragma unroll
        for (int ai = 0; ai < 2; ++ai)
#pragma unroll
            for (int m = 0; m < 4; ++m)
#pragma unroll
                for (int bj = 0; bj < 2; ++bj) { const unsigned e = e0 + (unsigned)((ai * 128 + m * 16) * D + bj * 128);
                    *(f32x4*)((char*)out + (size_t)(e * 4u)) = acc[ai][bj][m][0] * rr[ai][m] * fv[bj][0]; *(f32x4*)((char*)out + (size_t)(e * 4u + 16u)) = acc[ai][bj][m][1] * rr[ai][m] * fv[bj][1]; }
    }
    __device__ __forceinline__ void operator()(const f32x4 (&)[2][2][4][2], const Unit&, int, int, int, int) const {}
};
struct EpiCtxAtomic {
    static constexpr bool PERM = false; static constexpr bool AFTER_DRAIN = false;
    float* H; const float* gate; float gmul;
    __device__ __forceinline__ void operator()(const f32x4 (&acc)[2][2][4][2], const Unit& u, int wr, int wc, int fr, int fq) const {
        const int row0 = u.pm * 256 + wr * 64 + fr, col0 = u.pn * 256 + wc * 32 + 4 * fq;
#pragma unroll
        for (int bj = 0; bj < 2; ++bj)
#pragma unroll
            for (int n = 0; n < 2; ++n) { const f32x4 gv = *(const f32x4*)(gate + col0 + bj * 128 + n * 16) * gmul;
#pragma unroll
                for (int ai = 0; ai < 2; ++ai)
#pragma unroll
                    for (int m = 0; m < 4; ++m) { float* o = H + (size_t)(row0 + ai * 128 + m * 16) * D + col0 + bj * 128 + n * 16; const f32x4 v = gv * acc[ai][bj][m][n];
#pragma unroll
                        for (int i = 0; i < 4; ++i) unsafeAtomicAdd(o + i, v[i]); } }
    }
};
struct EpiMixIn {
    static constexpr bool PERM = true; static constexpr bool AFTER_DRAIN = false;
    unsigned char* ws; int ss_off;
    __device__ __forceinline__ void operator()(const f32x4 (&accr)[2][2][4][2], const Unit& u, int wr, int wc, int fr, int fq) const {
        const int row0 = u.pm * 256 + wr * 64 + fr;
        f32x4 acc[2][2][4][2];
        bf16_t *YG = (bf16_t*)(ws + WS_YG), *QB = (bf16_t*)(ws + WS_QB), *KB = (bf16_t*)(ws + WS_KB), *VTL = (bf16_t*)(ws + WS_VTL), *VTC = (bf16_t*)(ws + WS_VTC);
        const float* SSc = (const float*)(ws + WS_SS) + ss_off;
        { const int mb = u.pm < 64 ? (u.pm >> 4) : 4; const float* cbp = (const float*)(ws + WS_CBAB) + (size_t)mb * NAB + u.pn * 256 + wc * 32 + 8 * fq;
          f32x4 cv[2][2];
#pragma unroll
          for (int bj = 0; bj < 2; ++bj)
#pragma unroll
              for (int n = 0; n < 2; ++n) cv[bj][n] = *(const f32x4*)(cbp + bj * 128 + 4 * n);
#pragma unroll
          for (int ai = 0; ai < 2; ++ai)
#pragma unroll
              for (int m = 0; m < 4; ++m) { const float r = rstd_of(SSc[row0 + ai * 128 + m * 16]);
#pragma unroll
                  for (int bj = 0; bj < 2; ++bj)
#pragma unroll
                      for (int n = 0; n < 2; ++n) acc[ai][bj][m][n] = accr[ai][bj][m][n] * r + cv[bj][n]; } }
        if (u.pn < 4) {
            const int col0 = u.pn * 128 + wc * 32 + 8 * fq;
#pragma unroll
            for (int ai = 0; ai < 2; ++ai)
#pragma unroll
                for (int m = 0; m < 4; ++m) {
                    const f32x4 a0 = acc[ai][0][m][0], a1 = acc[ai][0][m][1], g0 = acc[ai][1][m][0], g1 = acc[ai][1][m][1];
                    u32x4 w;
                    w.x = cvt_pk_bf16(a0[0] * sigmoidf_(g0[0]), a0[1] * sigmoidf_(g0[1])); w.y = cvt_pk_bf16(a0[2] * sigmoidf_(g0[2]), a0[3] * sigmoidf_(g0[3]));
                    w.z = cvt_pk_bf16(a1[0] * sigmoidf_(g1[0]), a1[1] * sigmoidf_(g1[1])); w.w = cvt_pk_bf16(a1[2] * sigmoidf_(g1[2]), a1[3] * sigmoidf_(g1[3]));
                    ST16(3, YG + (size_t)(row0 + ai * 128 + m * 16) * 512 + col0, w);
                }
        } else if (u.pn < 8) {
            const bool isq = u.pn < 6; bf16_t* O = isq ? QB : KB; const float s = isq ? 0.125f : 1.0f;
            const int col0 = ((u.pn - 4) & 1) * 256 + wc * 32 + 8 * fq;
#pragma unroll
            for (int ai = 0; ai < 2; ++ai)
#pragma unroll
                for (int m = 0; m < 4; ++m)
#pragma unroll
                    for (int bj = 0; bj < 2; ++bj) {
                        const f32x4 v0 = acc[ai][bj][m][0] * s, v1 = acc[ai][bj][m][1] * s;
                        u32x4 w; w.x = cvt_pk_bf16(v0[0], v0[1]); w.y = cvt_pk_bf16(v0[2], v0[3]); w.z = cvt_pk_bf16(v1[0], v1[1]); w.w = cvt_pk_bf16(v1[2], v1[3]);
                        ST16(3, O + (size_t)(row0 + ai * 128 + m * 16) * 512 + col0 + bj * 128, w);
                    }
        } else {
            const int col0 = (u.pn - 8) * 256 + wc * 32 + 8 * fq;
#pragma unroll
            for (int ai = 0; ai < 2; ++ai)
#pragma unroll
                for (int m = 0; m < 4; ++m) {
                    const int row = row0 + ai * 128 + m * 16;
                    bf16_t* base; size_t dstride;
                    if (u.pm < 64) { const int b = row >> 12, n = row & 4095; base = VTL + (size_t)b * (512 * 4096) + n; dstride = 4096; }
                    else { const int rr = row - NTOK, b = rr >> 8, j = rr & 255; base = VTC + (size_t)b * (512 * 256) + j; dstride = 256; }
#pragma unroll
                    for (int bj = 0; bj < 2; ++bj)
#pragma unroll
                        for (int n = 0; n < 2; ++n)
#pragma unroll
                            for (int i = 0; i < 4; ++i) { const int c = col0 + bj * 128 + 4 * n + i;
                                const unsigned pk = cvt_pk_bf16(acc[ai][bj][m][n][i], 0.f);
                                PL2(base + (size_t)c * dstride, pk & 0xffffu); }
                }
        }
    }
};
struct EpiDftA {
    static constexpr bool PERM = true; static constexpr bool AFTER_DRAIN = false;
    unsigned char* ws; int ss_off;
    __device__ __forceinline__ void operator()(const f32x4 (&acc)[2][2][4][2], const Unit& u, int wr, int wc, int fr, int fq) const {
        const int rt0 = wr * 64 + fr, pcol0 = u.pn * 256 + wc * 32 + 8 * fq, col0 = u.pm * 4096 + pcol0;
        const int b = u.z >> 2, gr = u.z & 3;
        const float* SSc = (const float*)(ws + WS_SS) + ss_off; const float* cbd = (const float*)(ws + WS_CBD);
        bf16_t* tb = (bf16_t*)(ws + WS_T) + (size_t)u.z * (256 * (size_t)8192);
        f32x4 rc[2][2];
#pragma unroll
        for (int bj = 0; bj < 2; ++bj)
#pragma unroll
            for (int n = 0; n < 2; ++n) { const f32x4 sv = *(const f32x4*)(SSc + b * SEQ + pcol0 + bj * 128 + 4 * n);
                rc[bj][n] = (f32x4){rstd_of(sv[0]), rstd_of(sv[1]), rstd_of(sv[2]), rstd_of(sv[3])}; }
        float cmv[2][4];
#pragma unroll
        for (int ai = 0; ai < 2; ++ai)
#pragma unroll
            for (int m = 0; m < 4; ++m) cmv[ai][m] = cbd[(b * 4 + gr) * 512 + u.pm * 256 + rt0 + ai * 128 + m * 16];
#pragma unroll
        for (int ai = 0; ai < 2; ++ai)
#pragma unroll
            for (int m = 0; m < 4; ++m) {
                const int rt = rt0 + ai * 128 + m * 16; const float cm = cmv[ai][m];
#pragma unroll
                for (int bj = 0; bj < 2; ++bj) {
                    const f32x4 v0 = acc[ai][bj][m][0] * rc[bj][0] + cm, v1 = acc[ai][bj][m][1] * rc[bj][1] + cm;
                    u32x4 w; w.x = cvt_pk_bf16(v0[0], v0[1]); w.y = cvt_pk_bf16(v0[2], v0[3]); w.z = cvt_pk_bf16(v1[0], v1[1]); w.w = cvt_pk_bf16(v1[2], v1[3]);
                    ST16(4, tb + (size_t)rt * 8192 + col0 + bj * 128, w);
                } }
    }
};
typedef __amdgpu_buffer_rsrc_t rsrc_t;
struct EpiDftX {
    static constexpr bool PERM = true; static constexpr bool AFTER_DRAIN = true;
    unsigned char* ws;
    __device__ __forceinline__ void operator()(const f32x4 (&)[2][2][4][2], const Unit&, int, int, int, int) const {}
    __device__ __forceinline__ void fused(f32x4 (&acc)[2][2][4][2], const Unit& u, int wr, int wc, int fr, int fq) const {
        const int which = u.pn, bg = u.z, b = bg >> 2, gr = bg & 3, lane = threadIdx.x & 63, wave = threadIdx.x >> 6;
        const int row0 = u.pm * 256 + wr * 64 + fr, col0 = wc * 32 + 8 * fq;
        const rsrc_t rs = __builtin_amdgcn_make_buffer_rsrc((void*)ws, (short)0, (int)WS_TOTAL, 0x00020000);
        const unsigned own = (unsigned)(WS_XN + (size_t)(which * 16 + bg) * (2048 * 256) * 2), par = (unsigned)(WS_XN + (size_t)((1 - which) * 16 + bg) * (2048 * 256) * 2);
#pragma unroll
        for (int ai = 0; ai < 2; ++ai)
#pragma unroll
            for (int m = 0; m < 4; ++m)
#pragma unroll
                for (int bj = 0; bj < 2; ++bj) {
                    const f32x4 v0 = acc[ai][bj][m][0], v1 = acc[ai][bj][m][1];
                    u32x4 w; w.x = cvt_pk_bf16(v0[0], v0[1]); w.y = cvt_pk_bf16(v0[2], v0[3]); w.z = cvt_pk_bf16(v1[0], v1[1]); w.w = cvt_pk_bf16(v1[2], v1[3]);
                    __builtin_amdgcn_raw_buffer_store_b128(w, rs, own + (unsigned)(((row0 + ai * 128 + m * 16) * 256 + col0 + bj * 128) * 2), 0, 16);
                }
        asm volatile("s_waitcnt vmcnt(0)" ::: "memory");
        unsigned* cnt = (unsigned*)(ws + WS_CNTX) + 64 * (bg * 8 + u.pm);
        if (lane == 0) __hip_atomic_fetch_add(cnt, 1u, __ATOMIC_RELAXED, __HIP_MEMORY_SCOPE_AGENT);
        { unsigned spins = 0;
          while ((unsigned)__builtin_amdgcn_readfirstlane(__hip_atomic_load(cnt, __ATOMIC_RELAXED, __HIP_MEMORY_SCOPE_AGENT)) < 16u) { __builtin_amdgcn_s_sleep(2); if (++spins > (1u << 22)) break; } }
        bf16_t* F = (bf16_t*)(ws + WS_F);
#pragma unroll
        for (int ai = 0; ai < 2; ++ai)
#pragma unroll
            for (int m = 0; m < 4; ++m) {
                const int k = row0 + ai * 128 + m * 16, rout = which ? (SEQ - k) : k;
#pragma unroll
                for (int bj = 0; bj < 2; ++bj) {
                    const u32x4 pv = __builtin_amdgcn_raw_buffer_load_b128(rs, par + (unsigned)((k * 256 + col0 + bj * 128) * 2), 0, 16);
                    const f32x4 a0 = acc[ai][bj][m][0], a1 = acc[ai][bj][m][1];
                    const f32x4 p0 = (f32x4){__uint_as_float(pv[0] << 16), __uint_as_float(pv[0] & 0xffff0000u), __uint_as_float(pv[1] << 16), __uint_as_float(pv[1] & 0xffff0000u)};
                    const f32x4 p1 = (f32x4){__uint_as_float(pv[2] << 16), __uint_as_float(pv[2] & 0xffff0000u), __uint_as_float(pv[3] << 16), __uint_as_float(pv[3] & 0xffff0000u)};
                    const f32x4 o0 = which ? (p0 - a0) : (a0 + p0), o1 = which ? (p1 - a1) : (a1 + p1);
                    u32x4 w; w.x = cvt_pk_bf16(o0[0], o0[1]); w.y = cvt_pk_bf16(o0[2], o0[3]); w.z = cvt_pk_bf16(o1[0], o1[1]); w.w = cvt_pk_bf16(o1[2], o1[3]);
                    if (!(which && k == 0)) ST16(5, F + ((size_t)b * SEQ + rout) * D + gr * 256 + col0 + bj * 128, w);
                } }
        const bf16_t* T = (const bf16_t*)(ws + WS_T);
#pragma unroll
        for (int t = 0; t < 2; ++t) {
            const int m = (which * 8 + u.pm) * 16 + wave * 2 + t;
            const bf16_t* tp = T + ((size_t)bg * 256 + m) * 8192 + lane * 64;
            float sacc = 0.f;
#pragma unroll
            for (int j = 0; j < 8; ++j) { const u32x4 v = *(const u32x4*)(tp + 8 * j);
#pragma unroll
                for (int e = 0; e < 4; ++e) sacc += __uint_as_float(v[e] << 16) - __uint_as_float(v[e] & 0xffff0000u); }
            sacc = wave_sum(sacc) * 0.015625f;
            if (lane == 0) F[((size_t)b * SEQ + 2048) * D + gr * 256 + m] = (bf16_t)(cvt_pk_bf16(sacc, 0.f) & 0xffffu);
        }
    }
};

struct Params { const float* in[19]; float* out; unsigned char* ws; };
enum { I_X = 0, I_C, I_CTX, I_CCTX, I_ADAW, I_ADAB, I_NORMG, I_FFNWIN, I_FFNWOUT, I_ABWIN, I_CONVW, I_CONVB, I_CONVLNG, I_CONVLNB, I_RPB, I_ABWOUT, I_FNETW, I_FNETB, I_FINALG };

__device__ __forceinline__ void transpose_item(const float* W, int K, int N, bf16_t* WT, int n0src, int n0dst, int k0, LAS float* scr, int lane) {
    float v[32];
#pragma unroll
    for (int i = 0; i < 32; ++i) { const int kk = 2 * i + (lane >> 5); v[i] = W[(size_t)(k0 + kk) * N + n0src + (lane & 31)]; }
#pragma unroll
    for (int i = 0; i < 32; ++i) { const int kk = 2 * i + (lane >> 5); scr[kk * 33 + (lane & 31)] = v[i]; }
    asm volatile("s_waitcnt lgkmcnt(0)" ::: "memory");
    const int c = lane & 7;
#pragma unroll
    for (int j = 0; j < 4; ++j) { const int n = (lane >> 3) + 8 * j; const LAS float* s = scr + (8 * c) * 33 + n;
        u32x4 o; o.x = cvt_pk_bf16(s[0 * 33], s[1 * 33]); o.y = cvt_pk_bf16(s[2 * 33], s[3 * 33]); o.z = cvt_pk_bf16(s[4 * 33], s[5 * 33]); o.w = cvt_pk_bf16(s[6 * 33], s[7 * 33]);
        ST16(6, WT + (size_t)(n0dst + n) * K + k0 + 8 * c, o); }
    asm volatile("s_waitcnt lgkmcnt(0)" ::: "memory");
}
__device__ __forceinline__ int paired_src(int n0d, int Hs) { const int t = n0d >> 8, cp = n0d & 255; return cp < 128 ? t * 128 + cp : Hs + t * 128 + (cp - 128); }

__device__ __forceinline__ void gen_dftl(unsigned char* ws, LAS unsigned char* lds, int first) {
    const int tid = threadIdx.x, lane = tid & 63, wave = tid >> 6, nb = (int)gridDim.x - first, bi = (int)blockIdx.x - first;
    if (bi < 0) return;
    LAS float* lut = (LAS float*)lds;
    for (int i = tid; i < 4096; i += 512) lut[i] = cospif((float)i * (1.0f / 2048.0f));
    __syncthreads();
    bf16_t* DL = (bf16_t*)(ws + WS_DFTL);
    for (int k = bi * 8 + wave; k < 2048; k += nb * 8) {
        float cj[8], sj[8];
#pragma unroll
        for (int j = 0; j < 8; ++j) { const int idx = (k * j) & 4095; cj[j] = lut[idx] * 0.015625f; sj[j] = lut[(idx - 1024) & 4095] * 0.015625f; }
#pragma unroll
        for (int i = 0; i < 8; ++i) { const int n0 = 8 * (lane + 64 * i), idx0 = (k * n0) & 4095; const float c0 = lut[idx0], s0 = lut[(idx0 - 1024) & 4095]; float vc[8], vs[8];
#pragma unroll
            for (int j = 0; j < 8; ++j) { vc[j] = c0 * cj[j] - s0 * sj[j]; vs[j] = s0 * cj[j] + c0 * sj[j]; }
            u32x4 o; o.x = cvt_pk_bf16(vc[0], vc[1]); o.y = cvt_pk_bf16(vc[2], vc[3]); o.z = cvt_pk_bf16(vc[4], vc[5]); o.w = cvt_pk_bf16(vc[6], vc[7]);
            ST16(6, DL + (size_t)k * 8192 + n0, o);
            o.x = cvt_pk_bf16(vs[0], vs[1]); o.y = cvt_pk_bf16(vs[2], vs[3]); o.z = cvt_pk_bf16(vs[4], vs[5]); o.w = cvt_pk_bf16(vs[6], vs[7]);
            ST16(6, DL + (size_t)k * 8192 + 4096 + n0, o); }
    }
    __syncthreads();
}

__device__ __forceinline__ void prologue(const Params& p, LAS unsigned char* lds) {
    const int tid = threadIdx.x, lane = tid & 63, wave = tid >> 6, G = gridDim.x;
    unsigned char* ws = p.ws;
    {
        LAS float* sil = (LAS float*)lds;
        LAS float* part = (LAS float*)(lds + 20480);
        for (int i = tid; i < 5 * 1024; i += 512) { const int b = i >> 10, k = i & 1023; const float v = (b < 4) ? p.in[I_C][b * 1024 + k] : p.in[I_CCTX][k]; sil[i] = v / (1.0f + __expf(-v)); }
        __syncthreads();
        float* MOD = (float*)(ws + WS_MOD);
        const int cl = tid & 7, kr = tid >> 3;
        for (int item = blockIdx.x; item < 576; item += G) {
            const int l = item / 288, n0 = (item % 288) * 32;
            const float* wp = p.in[I_ADAW] + (size_t)l * 1024 * 9216 + n0 + 4 * cl;
            f32x4 acc[5];
#pragma unroll
            for (int b = 0; b < 5; ++b) acc[b] = (f32x4){0.f, 0.f, 0.f, 0.f};
#pragma unroll
            for (int s = 0; s < 16; ++s) { const int k = kr + 64 * s; const f32x4 w4 = *(const f32x4*)(wp + (size_t)k * 9216);
#pragma unroll
                for (int b = 0; b < 5; ++b) acc[b] += w4 * sil[b * 1024 + k]; }
#pragma unroll
            for (int b = 0; b < 5; ++b)
#pragma unroll
                for (int q = 0; q < 4; ++q) { float v = acc[b][q]; v += __shfl_xor(v, 8); v += __shfl_xor(v, 16); v += __shfl_xor(v, 32); acc[b][q] = v; }
            if (lane < 8) {
#pragma unroll
                for (int b = 0; b < 5; ++b)
#pragma unroll
                    for (int q = 0; q < 4; ++q) part[(wave * 5 + b) * 32 + 4 * lane + q] = acc[b][q];
            }
            __syncthreads();
            if (tid < 160) { const int b = tid >> 5, col = tid & 31; float s = p.in[I_ADAB][l * 9216 + n0 + col];
#pragma unroll
                for (int w = 0; w < 8; ++w) s += part[(w * 5 + b) * 32 + col];
                MOD[(size_t)(l * 5 + b) * 9216 + n0 + col] = s; }
            __syncthreads();
        }
    }
    __syncthreads();
    {
        LAS float* scr = (LAS float*)(lds + wave * 16384);
        const int gw = blockIdx.x * 8 + wave, NGW = G * 8;
        constexpr int I_W1 = 16 * 176, I_W2 = 44 * 32, I_AB = 16 * 80, I_SQ = 16 * 32;
        constexpr int NITEMS = 4 * I_W1 + 4 * I_W2 + I_AB + 2 * I_SQ;
        for (int it = gw; it < NITEMS; it += NGW) {
            int r = it;
            if (r < 4 * I_W1) { const int mi = r / I_W1; r -= mi * I_W1; const int kb = r / 176, nb = r % 176;
                transpose_item(p.in[I_FFNWIN] + (size_t)mi * D * NFF1, D, NFF1, (bf16_t*)(ws + WS_W1T + mi * SZ_W1T), paired_src(nb * 32, DFF), nb * 32, kb * 64, scr, lane); continue; }
            r -= 4 * I_W1;
            if (r < 4 * I_W2) { const int mi = r / I_W2; r -= mi * I_W2; const int kb = r / 32, nb = r % 32;
                transpose_item(p.in[I_FFNWOUT] + (size_t)mi * DFF * D, DFF, D, (bf16_t*)(ws + WS_W2T + mi * SZ_W2T), nb * 32, nb * 32, kb * 64, scr, lane); continue; }
            r -= 4 * I_W2;
            if (r < I_AB) { const int kb = r / 80, nb = r % 80; const int nd = nb * 32, nsrc = nd < 1024 ? paired_src(nd, 512) : nd;
                transpose_item(p.in[I_ABWIN], D, NAB, (bf16_t*)(ws + WS_WABT), nsrc, nd, kb * 64, scr, lane); continue; }
            r -= I_AB;
            if (r < I_SQ) { const int kb = r / 32, nb = r % 32; transpose_item(p.in[I_ABWOUT], D, D, (bf16_t*)(ws + WS_WOT), nb * 32, nb * 32, kb * 64, scr, lane); continue; }
            r -= I_SQ;
            { const int kb = r / 32, nb = r % 32; transpose_item(p.in[I_FNETW], D, D, (bf16_t*)(ws + WS_WFT), nb * 32, nb * 32, kb * 64, scr, lane); }
        }
    }
    __syncthreads();
    {
        LAS float* lut = (LAS float*)lds;
        for (int i = tid; i < 4096; i += 512) lut[i] = cospif((float)i * (1.0f / 2048.0f));
        __syncthreads();
        const int gt = blockIdx.x * 512 + tid, NT = G * 512;
        bf16_t* DC = (bf16_t*)(ws + WS_DFTC);
        for (int ch = gt; ch < 512 * 32; ch += NT) { const int mrow = ch >> 5, c0 = (ch & 31) * 8, m = mrow & 255, sp = mrow >> 8; float v[8];
#pragma unroll
            for (int j = 0; j < 8; ++j) { const int idx = ((m * (c0 + j)) & 255) * 16; v[j] = sp ? -lut[(idx - 1024) & 4095] * 0.0625f : lut[idx] * 0.0625f; }
            u32x4 o; o.x = cvt_pk_bf16(v[0], v[1]); o.y = cvt_pk_bf16(v[2], v[3]); o.z = cvt_pk_bf16(v[4], v[5]); o.w = cvt_pk_bf16(v[6], v[7]);
            *(u32x4*)(DC + (size_t)mrow * 256 + c0) = o; }
        { float* SS = (float*)(ws + WS_SS); for (int i = gt; i < 6 * MT; i += NT) SS[i] = 0.f; }
        { float* z = (float*)(ws + WS_SSF); for (int i = gt; i < (64 + 16 + 32) * 256; i += NT) z[i] = 0.f; }
        { float* ng = (float*)(ws + WS_NG); for (int i = gt; i < 6 * D; i += NT) ng[i] = p.in[I_NORMG][i]; }
        { float* Hc = (float*)(ws + WS_HC); const f32x4* src = (const f32x4*)p.in[I_CTX];
          for (int i = gt; i < NCTX * D / 4; i += NT) ((f32x4*)Hc)[i] = src[i]; }
    }
    __syncthreads();
}

__device__ __forceinline__ void prenorm_rows(const float* src0, const float* src1, int row_lo, int row_hi, const float* g, const float* scale, float* SS, bf16_t* HB) {
    const int lane = threadIdx.x & 63, wave = threadIdx.x >> 6, gw = blockIdx.x * 8 + wave, NGW = gridDim.x * 8;
    for (int row = row_lo + gw; row < row_hi; row += 2 * NGW) {
        const int rowb = row + NGW; const bool hasb = rowb < row_hi; const int rb = hasb ? rowb : row;
        const float* srca = row < NTOK ? src0 + (size_t)row * D : src1 + (size_t)(row - NTOK) * D;
        const float* srcb = rb < NTOK ? src0 + (size_t)rb * D : src1 + (size_t)(rb - NTOK) * D;
        const int mba = row < NTOK ? (row >> 12) : 4, mbb = rb < NTOK ? (rb >> 12) : 4;
        const f32x4* xa = (const f32x4*)srca + lane; const f32x4* xb = (const f32x4*)srcb + lane;
        f32x4 va[4], vb[4]; float sa = 0.f, sb = 0.f;
#pragma unroll
        for (int j = 0; j < 4; ++j) { va[j] = xa[64 * j]; vb[j] = xb[64 * j]; }
#pragma unroll
        for (int j = 0; j < 4; ++j) { sa += (va[j][0] * va[j][0] + va[j][1] * va[j][1]) + (va[j][2] * va[j][2] + va[j][3] * va[j][3]); sb += (vb[j][0] * vb[j][0] + vb[j][1] * vb[j][1]) + (vb[j][2] * vb[j][2] + vb[j][3] * vb[j][3]); }
        sa = wave_sum(sa); sb = wave_sum(sb);
        if (lane == 0) { SS[row] = sa; if (hasb) SS[rowb] = sb; }
        const f32x4* gp = (const f32x4*)g + lane;
        const f32x4* sca = (const f32x4*)(scale + (size_t)mba * 9216) + lane; const f32x4* scb = (const f32x4*)(scale + (size_t)mbb * 9216) + lane;
        u32x2* oa = (u32x2*)(HB + (size_t)row * D) + lane; u32x2* ob = (u32x2*)(HB + (size_t)rb * D) + lane;
#pragma unroll
        for (int j = 0; j < 4; ++j) { const f32x4 gj = gp[64 * j]; const f32x4 za = va[j] * gj * (sca[64 * j] + 1.0f), zb = vb[j] * gj * (scb[64 * j] + 1.0f);
            u32x2 w; w.x = cvt_pk_bf16(za[0], za[1]); w.y = cvt_pk_bf16(za[2], za[3]); oa[64 * j] = w;
            if (hasb) { w.x = cvt_pk_bf16(zb[0], zb[1]); w.y = cvt_pk_bf16(zb[2], zb[3]); ob[64 * j] = w; } }
    }
}
__device__ __forceinline__ void cb_item(const bf16_t* WT, int ldw, int K, int n0, const float* shift, float* out, int ostride, int lane) {
    const bf16_t* wp = WT + (size_t)(n0 + lane) * ldw;
    float a[5] = {0.f, 0.f, 0.f, 0.f, 0.f};
#pragma unroll 4
    for (int k8 = 0; k8 < K; k8 += 8) {
        const u32x4 q = *(const u32x4*)(wp + k8);
        float w[8];
#pragma unroll
        for (int e = 0; e < 4; ++e) { w[2 * e] = __uint_as_float(q[e] << 16); w[2 * e + 1] = __uint_as_float(q[e] & 0xffff0000u); }
#pragma unroll
        for (int b = 0; b < 5; ++b) { const float* sp = shift + (size_t)b * 9216 + k8;
#pragma unroll
            for (int e = 0; e < 8; ++e) a[b] += w[e] * sp[e]; }
    }
#pragma unroll
    for (int b = 0; b < 5; ++b) out[(size_t)b * ostride + n0 + lane] = a[b];
}
__device__ __forceinline__ void cb_tables(const Params& p) {
    const int lane = threadIdx.x & 63, wave = threadIdx.x >> 6, G = gridDim.x;
    unsigned char* ws = p.ws; const float* MOD = (const float*)(ws + WS_MOD);
    for (int it = blockIdx.x + G * wave; it < 4 * 88 + 40 + 32; it += 8 * G) {
        if (it < 352) { const int mi = it / 88, ch = it % 88, layer = mi >> 1, sub = mi & 1;
            cb_item((const bf16_t*)(ws + WS_W1T + mi * SZ_W1T), D, D, ch * 64, MOD + (size_t)layer * 5 * 9216 + (sub ? 6 : 0) * 1024, (float*)(ws + WS_CB) + (size_t)mi * 5 * NFF1, NFF1, lane); }
        else if (it < 392) { const int ch = it - 352; cb_item((const bf16_t*)(ws + WS_WABT), D, D, ch * 64, MOD + 3 * 1024, (float*)(ws + WS_CBAB), NAB, lane); }
        else { const int e = it - 392, gr = e >> 3, ch = e & 7;
            cb_item((const bf16_t*)(ws + WS_DFTC), 256, 256, ch * 64, MOD + (size_t)5 * 9216 + 3 * 1024 + gr * 256, (float*)(ws + WS_CBD) + gr * 512, 2048, lane); }
    }
}
__device__ __forceinline__ void final_norm_phase(const float* H, const float* g, float* out) {
    const int lane = threadIdx.x & 63, wave = threadIdx.x >> 6, gw = blockIdx.x * 8 + wave, NGW = gridDim.x * 8;
    for (int row = gw; row < NTOK; row += NGW) {
        const f32x4* xr = (const f32x4*)(H + (size_t)row * D) + lane;
        f32x4 v[4]; float s = 0.f;
#pragma unroll
        for (int j = 0; j < 4; ++j) { v[j] = xr[64 * j]; s += (v[j][0] * v[j][0] + v[j][1] * v[j][1]) + (v[j][2] * v[j][2] + v[j][3] * v[j][3]); }
        const float rstd = rsqrtf(wave_sum(s) * (1.0f / D) + 1e-6f);
        const f32x4* gp = (const f32x4*)g + lane; f32x4* o = (f32x4*)(out + (size_t)row * D) + lane;
#pragma unroll
        for (int j = 0; j < 4; ++j) o[64 * j] = v[j] * rstd * gp[64 * j];
    }
}

__device__ __forceinline__ float xrow16_max(float x) {
    auto s_ = __builtin_amdgcn_permlane16_swap(__float_as_uint(x), __float_as_uint(x), false, false);
    x = fmaxf(__uint_as_float(s_[0]), __uint_as_float(s_[1]));
    auto t_ = __builtin_amdgcn_permlane32_swap(__float_as_uint(x), __float_as_uint(x), false, false);
    return fmaxf(__uint_as_float(t_[0]), __uint_as_float(t_[1]));
}
__device__ __forceinline__ float xrow16_sum(float x) {
    auto s_ = __builtin_amdgcn_permlane16_swap(__float_as_uint(x), __float_as_uint(x), false, false);
    x = __uint_as_float(s_[0]) + __uint_as_float(s_[1]);
    auto t_ = __builtin_amdgcn_permlane32_swap(__float_as_uint(x), __float_as_uint(x), false, false);
    return __uint_as_float(t_[0]) + __uint_as_float(t_[1]);
}
struct AttnState { float m, l; f32x4 o[4]; };
__device__ __forceinline__ void attn_group(AttnState& st, const bf16x8 (&kf)[4], const bf16x8 (&vf)[4], const bf16x8 q0, const bf16x8 q1, int cb, int w, const LAS float* rlrow, int g) {
    f32x4 a1 = (f32x4){0.f, 0.f, 0.f, 0.f}, a2 = (f32x4){0.f, 0.f, 0.f, 0.f};
    __builtin_amdgcn_s_setprio(1);
    a1 = __builtin_amdgcn_mfma_f32_16x16x32_bf16(kf[0], q0, a1, 0, 0, 0); a1 = __builtin_amdgcn_mfma_f32_16x16x32_bf16(kf[1], q1, a1, 0, 0, 0);
    a2 = __builtin_amdgcn_mfma_f32_16x16x32_bf16(kf[2], q0, a2, 0, 0, 0); a2 = __builtin_amdgcn_mfma_f32_16x16x32_bf16(kf[3], q1, a2, 0, 0, 0);
    __builtin_amdgcn_s_setprio(0);
    float s[8]; bool ok[8];
#pragma unroll
    for (int e = 0; e < 8; ++e) s[e] = e < 4 ? a1[e] : a2[e - 4];
    if (cb >= 0) {
        const int cs = min(max(w - 8, 0), 48);
#pragma unroll
        for (int e = 0; e < 8; ++e) { const int c = cb + 8 * g + e; ok[e] = (c >= cs) && (c < cs + 16); const int co = c - w + 15; const float bias = rlrow[ok[e] ? co : 0]; s[e] = ok[e] ? s[e] + bias : -1e30f; }
    } else {
#pragma unroll
        for (int e = 0; e < 8; ++e) ok[e] = true;
    }
    float mx = fmaxf(fmaxf(fmaxf(s[0], s[1]), fmaxf(s[2], s[3])), fmaxf(fmaxf(s[4], s[5]), fmaxf(s[6], s[7])));
    mx = xrow16_max(mx);
    const bool keep = __all(mx - st.m <= 8.0f);
    float mnew = st.m;
    if (!keep) { mnew = fmaxf(st.m, mx); const float alpha = fast_exp(st.m - mnew); st.l *= alpha; st.m = mnew;
#pragma unroll
        for (int dt = 0; dt < 4; ++dt) st.o[dt] = st.o[dt] * alpha; }
    float pe[8], ps = 0.f;
#pragma unroll
    for (int e = 0; e < 8; ++e) { pe[e] = ok[e] ? fast_exp(s[e] - mnew) : 0.f; ps += pe[e]; }
    st.l += ps;
    union { u32x4 u; bf16x8 v; } pb;
    pb.u.x = cvt_pk_bf16(pe[0], pe[1]); pb.u.y = cvt_pk_bf16(pe[2], pe[3]); pb.u.z = cvt_pk_bf16(pe[4], pe[5]); pb.u.w = cvt_pk_bf16(pe[6], pe[7]);
#pragma unroll
    for (int dt = 0; dt < 4; ++dt) { if (dt == 0) __builtin_amdgcn_s_setprio(1); st.o[dt] = __builtin_amdgcn_mfma_f32_16x16x32_bf16(vf[dt], pb.v, st.o[dt], 0, 0, 0); }
    __builtin_amdgcn_s_setprio(0);
}

__device__ __forceinline__ void attn_unit(int u, const bf16_t* QB, const bf16_t* KB, const bf16_t* VTL, const bf16_t* VTC, const float* rpb, bf16_t* MIX, LAS float* rl, int lane) {
    const int r = u & 63, h = (u >> 6) & 7, b = u >> 9;
    const int rs = min(max(r - 4, 0), 56);
    const int qi = lane & 15, g = lane >> 4;
    for (int i = lane; i < 465; i += 64) { const int ro = i / 31, co = i - ro * 31; rl[ro * 32 + co] = rpb[h * 465 + i]; }
    asm volatile("s_waitcnt lgkmcnt(0)" ::: "memory");
    AttnState st[4];
    LAS bf16x8* qs = (LAS bf16x8*)(rl + 512) + lane;
#pragma unroll
    for (int qb = 0; qb < 4; ++qb) { st[qb].m = -1e30f; st[qb].l = 0.f;
#pragma unroll
        for (int dt = 0; dt < 4; ++dt) st[qb].o[dt] = (f32x4){0.f, 0.f, 0.f, 0.f};
        const size_t tq = (size_t)b * SEQ + r * 64 + 16 * qb + qi;
        qs[(qb * 2 + 0) * 64] = *(const bf16x8*)(QB + tq * 512 + h * 64 + 8 * g); qs[(qb * 2 + 1) * 64] = *(const bf16x8*)(QB + tq * 512 + h * 64 + 32 + 8 * g); }
    asm volatile("s_waitcnt lgkmcnt(0)" ::: "memory");
    const int kap = 8 * (qi >> 2) + (qi & 3);
    const bf16_t* vtl = VTL + ((size_t)(b * 8 + h) * 64 + qi) * 4096 + 8 * g;
    const bf16_t* vtc = VTC + ((size_t)(b * 8 + h) * 64 + qi) * 256 + 8 * g;
    const bf16_t* kl = KB + ((size_t)b * SEQ + kap) * 512 + h * 64 + 8 * g;
    const bf16_t* kc = KB + ((size_t)NTOK + b * 256 + kap) * 512 + h * 64 + 8 * g;
#define ATT_LOAD(kf, vf, kp, vp, vs) do { kf[0] = *(const bf16x8*)(kp); kf[1] = *(const bf16x8*)((kp) + 32); kf[2] = *(const bf16x8*)((kp) + 4 * 512); kf[3] = *(const bf16x8*)((kp) + 4 * 512 + 32); \
        _Pragma("unroll") for (int dt = 0; dt < 4; ++dt) vf[dt] = *(const bf16x8*)((vp) + (size_t)dt * (vs)); } while (0)
    bf16x8 kA[4], vA[4], kB[4], vB[4];
    ATT_LOAD(kA, vA, kl + (size_t)(rs * 64) * 512, vtl + rs * 64, 16 * 4096);
    for (int a = 0; a < 8; ++a) {
        const int kr = rs + a;
        const LAS float* rlrow = rl + (kr - r + 7) * 32;
        ATT_LOAD(kB, vB, kl + (size_t)(kr * 64 + 32) * 512, vtl + kr * 64 + 32, 16 * 4096);
        __builtin_amdgcn_sched_barrier(0);
#pragma unroll
        for (int qb = 0; qb < 3; ++qb) attn_group(st[qb], kA, vA, qs[(qb * 2 + 0) * 64], qs[(qb * 2 + 1) * 64], 0, 16 * qb + qi, rlrow, g);
        { const bool more = a < 7;
          const bf16_t* kpn = more ? kl + (size_t)((kr + 1) * 64) * 512 : kc; const bf16_t* vpn = more ? vtl + (kr + 1) * 64 : vtc; const int vsn = more ? 16 * 4096 : 16 * 256;
          ATT_LOAD(kA, vA, kpn, vpn, vsn); }
        __builtin_amdgcn_sched_barrier(0);
#pragma unroll
        for (int qb = 1; qb < 4; ++qb) attn_group(st[qb], kB, vB, qs[(qb * 2 + 0) * 64], qs[(qb * 2 + 1) * 64], 32, 16 * qb + qi, rlrow, g);
    }
    for (int cgp = 0; cgp < 8; cgp += 2) {
        ATT_LOAD(kB, vB, kc + (size_t)(32 * (cgp + 1)) * 512, vtc + 32 * (cgp + 1), 16 * 256);
        __builtin_amdgcn_sched_barrier(0);
#pragma unroll
        for (int qb = 0; qb < 4; ++qb) attn_group(st[qb], kA, vA, qs[(qb * 2 + 0) * 64], qs[(qb * 2 + 1) * 64], -1, 0, rl, g);
        if (cgp + 2 < 8) ATT_LOAD(kA, vA, kc + (size_t)(32 * (cgp + 2)) * 512, vtc + 32 * (cgp + 2), 16 * 256);
        __builtin_amdgcn_sched_barrier(0);
#pragma unroll
        for (int qb = 0; qb < 4; ++qb) attn_group(st[qb], kB, vB, qs[(qb * 2 + 0) * 64], qs[(qb * 2 + 1) * 64], -1, 0, rl, g);
    }
#undef ATT_LOAD
#pragma unroll
    for (int qb = 0; qb < 4; ++qb) {
        const float l = xrow16_sum(st[qb].l);
        const float inv = 1.0f / l;
        const size_t tq = (size_t)b * SEQ + r * 64 + 16 * qb + qi;
#pragma unroll
        for (int dt = 0; dt < 4; ++dt) { const f32x4 o = st[qb].o[dt] * inv; u32x2 w; w.x = cvt_pk_bf16(o[0], o[1]); w.y = cvt_pk_bf16(o[2], o[3]);
            PL8(MIX + tq * D + 512 + h * 64 + dt * 16 + 4 * g, w); }
    }
}

__device__ __forceinline__ void conv_phase(const Params& p, const bf16_t* YG, bf16_t* MIX, LAS unsigned char* lds, unsigned* counter) {
    constexpr int TT = 32, NIT = NTOK / TT;
    const int tid = threadIdx.x, lane = tid & 63, wave = tid >> 6, c = tid;
    LAS float* red = (LAS float*)lds;
    LAS float* stat = (LAS float*)(lds + TT * 2048);
    float w[31];
#pragma unroll
    for (int j = 0; j < 31; ++j) w[j] = p.in[I_CONVW][j * 512 + c];
    const float cb = p.in[I_CONVB][c], lg = p.in[I_CONVLNG][c], lb = p.in[I_CONVLNB][c];
    LAS int* qslot = (LAS int*)(lds + TT * 2048 + 1024);
    for (;;) {
        if (tid == 0) *qslot = (int)atomicAdd(counter, 1u);
        __syncthreads();
        const int item = *qslot;
        if (item >= NIT) break;
        const int t0 = item * TT, b = t0 >> 12, n0 = t0 & 4095;
        float in[TT + 30];
#pragma unroll
        for (int i = 0; i < TT + 30; ++i) { const int n = n0 - 15 + i; in[i] = (n >= 0 && n < SEQ) ? bf2f(YG[((size_t)b * SEQ + n) * 512 + c]) : 0.f; }
        float y[TT];
#pragma unroll
        for (int t = 0; t < TT; ++t) { float a = cb;
#pragma unroll
            for (int j = 0; j < 31; ++j) a += in[t + j] * w[j];
            y[t] = a; }
#pragma unroll
        for (int t = 0; t < TT; ++t) red[t * 512 + c] = y[t];
        __syncthreads();
#pragma unroll
        for (int tt = 0; tt < TT / 8; ++tt) { const int t = (TT / 8) * wave + tt; float s = 0.f;
#pragma unroll
            for (int i = 0; i < 8; ++i) s += red[t * 512 + lane + 64 * i];
            s = wave_sum(s); if (lane == 0) stat[t] = s * (1.0f / 512.0f); }
        __syncthreads();
#pragma unroll
        for (int t = 0; t < TT; ++t) { y[t] -= stat[t]; red[t * 512 + c] = y[t] * y[t]; }
        __syncthreads();
#pragma unroll
        for (int tt = 0; tt < TT / 8; ++tt) { const int t = (TT / 8) * wave + tt; float s = 0.f;
#pragma unroll
            for (int i = 0; i < 8; ++i) s += red[t * 512 + lane + 64 * i];
            s = wave_sum(s); if (lane == 0) stat[TT + t] = rsqrtf(s * (1.0f / 512.0f) + 1e-6f); }
        __syncthreads();
#pragma unroll
        for (int t = 0; t < TT; ++t) { const float z = y[t] * stat[TT + t] * lg + lb; const unsigned pk = cvt_pk_bf16(siluf_(z), 0.f);
            PL2(MIX + (size_t)(t0 + t) * D + c, pk & 0xffffu); }
        __syncthreads();
    }
}

__global__ void __launch_bounds__(512, 2) mega(Params p) {
    extern __shared__ __attribute__((aligned(16))) unsigned char lds_raw[];
    LAS unsigned char* lds = (LAS unsigned char*)lds_raw;
    cg::grid_group grid = cg::this_grid();
    const int G = gridDim.x, c = blockIdx.x;
    volatile LAS unsigned* bst = (volatile LAS unsigned*)(lds + 131072 + 64);
    if (threadIdx.x < 2) bst[threadIdx.x] = 0u;
    __syncthreads();
    const XcdBarrier xbar = xcd_barrier_post((unsigned*)(p.ws + WS_BAR), bst);
    if (G > (1 << 20)) grid.sync();
#define GSYNC() xcd_barrier(xbar)
    const int vcu = (G % 8 == 0) ? (c % 8) * (G / 8) + c / 8 : c;
    unsigned char* ws = p.ws;
    float* MOD = (float*)(ws + WS_MOD);
    float* HC = (float*)(ws + WS_HC);
    bf16_t* XN = (bf16_t*)(ws + WS_XN);
    bf16_t* ACT = (bf16_t*)(ws + WS_ACT);
    bf16_t* MIX = (bf16_t*)(ws + WS_MIX); bf16_t* F = (bf16_t*)(ws + WS_F);
    bf16_t *YG = (bf16_t*)(ws + WS_YG), *QB = (bf16_t*)(ws + WS_QB), *KB = (bf16_t*)(ws + WS_KB), *VTL = (bf16_t*)(ws + WS_VTL), *VTC = (bf16_t*)(ws + WS_VTC);
    bf16_t* T = (bf16_t*)(ws + WS_T);

    prologue(p, lds);
    GSYNC();

    float* SS = (float*)(ws + WS_SS);
    const float* NG = p.in[I_NORMG];
    const float* MOD1 = MOD + (size_t)5 * 9216;

    prenorm_rows(p.in[I_X], p.in[I_CTX], 0, MT, NG, MOD + 1 * 1024, SS, XN);
    cb_tables(p);
    GSYNC();

#define FFN_SUBLAYER(inst, nrows, SRC0, SRC1, LASTSUB)                                                                                                 \
    {                                                                                                                                                  \
        constexpr int layer_ = (inst) / 3, sub_ = ((inst) % 3) ? 1 : 0, mi_ = layer_ * 2 + sub_, nx_ = (inst) + 1;                                     \
        const float* mod_l = MOD + (size_t)layer_ * 5 * 9216;                                                                                          \
        { pg8::Gemm g{D, D, D}; PlainOrder S{(const char*)XN, (const char*)(ws + WS_W1T + mi_ * SZ_W1T), (size_t)256 * D * 2, (size_t)256 * D * 2, (nrows) / 256, NFF1 / 256, G, c}; \
          EpiSwiglu E{ws, (inst) * MT, mi_ * 5 * NFF1}; pg8::gemm_phase(lds, g, S, E); }                     \
        GSYNC();                                                                                                                                       \
        { pg8::Gemm g{DFF, DFF, DFF}; PlainOrder S{(const char*)ACT, (const char*)(ws + WS_W2T + mi_ * SZ_W2T), (size_t)256 * DFF * 2, (size_t)256 * DFF * 2, NTOK / 256, D / 256, G, c}; \
          EpiResid<!(LASTSUB), (inst) != 0, false> E{ws, (SRC0), (SRC1), nullptr, 0.5f, layer_ * 5 * 9216 + (sub_ ? 8 : 2) * 1024, nx_ * MT, nx_ * D, (nx_ / 3) * 5 * 9216 + (3 * (nx_ % 3) + 1) * 1024};              \
          pg8::gemm_phase(lds, g, S, E); }                                                                                                             \
        if ((nrows) > NTOK) { pg8::Gemm g{DFF, DFF, 256}; CtxSplitOrder S{(const char*)ACT, (const char*)(ws + WS_W2T), G, c}; EpiCtxAtomic E{HC, mod_l + 4 * 9216 + 2 * 1024, 0.5f}; pg8::gemm_phase(lds, g, S, E); } \
        GSYNC();                                                                                                                                       \
    }

    FFN_SUBLAYER(0, MT, p.in[I_X], p.in[I_CTX] - (size_t)NTOK * D, false);
    prenorm_rows(nullptr, HC, NTOK, MT, NG + 1 * D, MOD + 4 * 1024, SS + (size_t)1 * MT, XN);
    gen_dftl(ws, lds, 128);
    { pg8::Gemm g{D, D, D}; MixInOrder S{(const char*)XN, (const char*)(ws + WS_WABT), G, c, 0, 640}; EpiMixIn E{ws, 1 * MT}; pg8::gemm_phase(lds, g, S, E); }
    GSYNC();
    { pg8::Gemm g{D, D, D}; MixInOrder S{(const char*)XN, (const char*)(ws + WS_WABT), G, c, 640, 656}; EpiMixIn E{ws, 1 * MT}; pg8::gemm_phase(lds, g, S, E); }
    conv_phase(p, YG, MIX, lds, (unsigned*)(ws + WS_BAR) + CNT_WORD);
    GSYNC();
    {
        const int wave = threadIdx.x >> 6, lane = threadIdx.x & 63;
        LAS float* rl = (LAS float*)(lds + 40960 + wave * 10240);
        for (int u = c * 8 + wave; u < 2048; u += G * 8) attn_unit(u, QB, KB, VTL, VTC, p.in[I_RPB], MIX, rl, lane);
    }
    GSYNC();
    { pg8::Gemm g{D, D, D}; PlainOrder S{(const char*)MIX, (const char*)(ws + WS_WOT), (size_t)256 * D * 2, (size_t)256 * D * 2, NTOK / 256, D / 256, G, c};
      EpiResid<true, true, false> E{ws, nullptr, nullptr, nullptr, 1.0f, 5 * 1024, 2 * MT, 2 * D, 7 * 1024}; pg8::gemm_phase(lds, g, S, E); }
    GSYNC();
    FFN_SUBLAYER(2, NTOK, nullptr, nullptr, false);

    FFN_SUBLAYER(3, NTOK, nullptr, nullptr, false);
    { pg8::Gemm g{256, D, 256}; DftAOrder S{(const char*)(ws + WS_DFTC), (const char*)XN, G, vcu}; EpiDftA E{ws, 4 * MT}; pg8::gemm_phase(lds, g, S, E); }
    GSYNC();
    { pg8::Gemm g{8192, 8192, 4096}; DftBOrder S{(const char*)(ws + WS_DFTL), (const char*)T, G, vcu}; EpiDftX E{ws}; pg8::gemm_phase(lds, g, S, E); }
    GSYNC();
    { pg8::Gemm g{D, D, D}; PlainOrder S{(const char*)F, (const char*)(ws + WS_WFT), (size_t)256 * D * 2, (size_t)256 * D * 2, NTOK / 256, D / 256, G, c};
      EpiResid<true, true, true> E{ws, nullptr, nullptr, p.in[I_FNETB], 1.0f, 5 * 9216 + 5 * 1024, 5 * MT, 5 * D, 5 * 9216 + 7 * 1024}; pg8::gemm_phase(lds, g, S, E); }
    GSYNC();
    { pg8::Gemm g{D, D, D}; PlainOrder S{(const char*)XN, (const char*)(ws + WS_W1T + 3 * SZ_W1T), (size_t)256 * D * 2, (size_t)256 * D * 2, NTOK / 256, NFF1 / 256, G, c};
      EpiSwiglu E{ws, 5 * MT, 3 * 5 * NFF1}; pg8::gemm_phase(lds, g, S, E); }
    GSYNC();
    { pg8::Gemm g{DFF, DFF, DFF}; PlainOrder S{(const char*)ACT, (const char*)(ws + WS_W2T + 3 * SZ_W2T), (size_t)256 * DFF * 2, (size_t)256 * DFF * 2, NTOK / 256, D / 256, G, c};
      EpiFinal E{ws, p.out, p.in[I_FINALG], 5 * 9216 + 8 * 1024}; pg8::gemm_phase(lds, g, S, E); }
}

extern "C" void kernel_launch(void* const* d_in, const int* in_sizes, int n_in, void* d_out, int out_size, void* d_ws, size_t ws_size, hipStream_t stream) {
    static int grid = 0;
    if (grid == 0) {
        int dev = 0, cus = 0, per_cu = 0;
        (void)hipGetDevice(&dev);
        (void)hipDeviceGetAttribute(&cus, hipDeviceAttributeMultiprocessorCount, dev);
        (void)hipFuncSetAttribute((const void*)mega, hipFuncAttributeMaxDynamicSharedMemorySize, LDS_BYTES);
        (void)hipOccupancyMaxActiveBlocksPerMultiprocessor(&per_cu, (const void*)mega, 512, LDS_BYTES);
        fprintf(stderr, "kernel_launch: cus %d per_cu %d ws %zu need %zu\n", cus, per_cu, ws_size, (size_t)WS_TOTAL);
        if (n_in != 19 || ws_size < WS_TOTAL || per_cu < 1) { fprintf(stderr, "kernel_launch: unexpected configuration; nothing launched\n"); grid = -1; return; }
        grid = cus;
    }
    if (grid < 0) return;
    Params p{};
    for (int i = 0; i < 19; ++i) p.in[i] = (const float*)d_in[i];
    p.out = (float*)d_out; p.ws = (unsigned char*)d_ws;
    (void)hipMemsetAsync((char*)d_ws + WS_BAR, 0, 16384, stream);
    void* args[] = {&p};
    hipError_t e = hipLaunchCooperativeKernel((const void*)mega, dim3(grid), dim3(512), args, LDS_BYTES, stream);
    if (e != hipSuccess) fprintf(stderr, "cooperative launch failed: %s (grid %d)\n", hipGetErrorString(e), grid);
}
```

```cpp
#define NTG 0x21
#include <hip/hip_runtime.h>
#include <hip/hip_cooperative_groups.h>
#include <cstdio>
#include <cstdint>
namespace cg = cooperative_groups;

#define LAS __attribute__((address_space(3)))
typedef unsigned short bf16_t;
typedef short bf16x8 __attribute__((ext_vector_type(8)));
typedef float f32x4 __attribute__((ext_vector_type(4)));
typedef unsigned u32x4 __attribute__((ext_vector_type(4)));
typedef unsigned u32x2 __attribute__((ext_vector_type(2)));

constexpr int D = 1024, SEQ = 4096, NTOK = 16384, NCTX = 1024, MT = NTOK + NCTX, DFF = 2816, NFF1 = 2 * DFF, NAB = 2560;
constexpr int LDS_BYTES = 147456;

constexpr size_t WS_MOD = 0;
constexpr size_t WS_NG = 360u << 10;
constexpr size_t WS_BAR = 384u << 10;
constexpr int    CNT_WORD = 3584;
constexpr size_t WS_SS = 400u << 10;
constexpr size_t WS_SSF = 816u << 10;
constexpr size_t WS_CNTF = 880u << 10;
constexpr size_t WS_CNTX = 896u << 10;
constexpr size_t WS_CB = 1u << 20;
constexpr size_t WS_CBAB = WS_CB + (size_t)4 * 5 * 5632 * 4;
constexpr size_t WS_CBD = WS_CBAB + (size_t)5 * 2560 * 4;
static_assert(WS_SS + (size_t)6 * 17408 * 4 <= WS_CB && WS_CBD + 5 * 2048 * 4 <= (2u << 20), "small tables fit");
constexpr size_t WS_W1T = 2u << 20;
constexpr size_t SZ_W1T = (size_t)NFF1 * D * 2;
constexpr size_t WS_W2T = WS_W1T + 4 * SZ_W1T;
constexpr size_t SZ_W2T = (size_t)D * DFF * 2;
constexpr size_t WS_WABT = WS_W2T + 4 * SZ_W2T;
constexpr size_t WS_WOT = WS_WABT + (size_t)NAB * D * 2;
constexpr size_t WS_WFT = WS_WOT + (size_t)D * D * 2;
constexpr size_t WS_DFTC = WS_WFT + (size_t)D * D * 2;
constexpr size_t WS_DFTL = WS_DFTC + 512 * 256 * 2;
constexpr size_t WS_H = WS_DFTL + (size_t)4096 * 8192 * 2;
constexpr size_t WS_HC = WS_H + (size_t)NTOK * D * 2;
constexpr size_t WS_XN = WS_HC + (size_t)NCTX * D * 4;
constexpr size_t WS_ACT = WS_XN + (size_t)MT * D * 2;
constexpr size_t WS_END = WS_ACT + (size_t)MT * DFF * 2;
constexpr size_t WS_YG = WS_ACT;
constexpr size_t WS_QB = WS_YG + (size_t)NTOK * 512 * 2;
constexpr size_t WS_KB = WS_QB + (size_t)NTOK * 512 * 2;
constexpr size_t WS_VTL = WS_KB + (size_t)MT * 512 * 2;
constexpr size_t WS_VTC = WS_VTL + (size_t)NTOK * 512 * 2;
static_assert(WS_VTC + (size_t)NCTX * 512 * 2 <= WS_END, "mixer aliases fit");
constexpr size_t WS_MIX = WS_VTC + (size_t)NCTX * 512 * 2;
constexpr size_t WS_T = WS_ACT;
constexpr size_t WS_F = WS_T + (size_t)16 * 256 * 8192 * 2;
constexpr size_t WS_TOTAL = (WS_MIX + (size_t)NTOK * D * 2) > (WS_F + (size_t)NTOK * D * 2) ? (WS_MIX + (size_t)NTOK * D * 2) : (WS_F + (size_t)NTOK * D * 2);

__device__ __forceinline__ float wave_sum(float v) {
#pragma unroll
    for (int o = 1; o < 64; o <<= 1) v += __shfl_xor(v, o);
    return v;
}
__device__ __forceinline__ unsigned cvt_pk_bf16(float lo, float hi) { unsigned r; asm volatile("v_cvt_pk_bf16_f32 %0, %1, %2" : "=v"(r) : "v"(lo), "v"(hi)); return r; }
#define NT16(p, v) __builtin_nontemporal_store((v), (u32x4*)(p))
#define PL16(p, v) (*(u32x4*)(p) = (v))
#define PL8(p, v) (*(u32x2*)(p) = (v))
#define PL2(p, v) (*(bf16_t*)(p) = (bf16_t)(v))
#ifndef NTG
#define NTG 1
#endif
#define ST16(grp, p, v) do { if ((NTG >> (grp)) & 1) NT16(p, v); else PL16(p, v); } while (0)
__device__ __forceinline__ float bf2f(unsigned short b) { return __uint_as_float(((unsigned)b) << 16); }
__device__ __forceinline__ float fast_exp(float x) { return __builtin_amdgcn_exp2f(x * 1.44269504089f); }
__device__ __forceinline__ float sigmoidf_(float x) { return __builtin_amdgcn_rcpf(1.0f + fast_exp(-x)); }
__device__ __forceinline__ float siluf_(float x) { return x * sigmoidf_(x); }


#define XB_TMO      128
#define XB_XCNT(j)  (256  + 64 * (j))
#define XB_XSUB(j)  (1280 + 64 * (j))
#define XB_XGEN(j)  (2304 + 64 * (j))
#define XB_TOP      3328
#define XB_TOPGEN   3392
#define XCD_BAR_WORDS 3456
#define XB_SPIN_CAP (1u << 18)
__device__ __forceinline__ unsigned xb_ld(unsigned* p)              { return __hip_atomic_load(p, __ATOMIC_RELAXED, __HIP_MEMORY_SCOPE_AGENT); }
__device__ __forceinline__ unsigned xb_add(unsigned* p, unsigned v) { return __hip_atomic_fetch_add(p, v, __ATOMIC_RELAXED, __HIP_MEMORY_SCOPE_AGENT); }
__device__ __forceinline__ unsigned xb_xcc_id() { return (unsigned)__builtin_amdgcn_s_getreg((3 << 11) | 20) & 0xFu; }
#ifndef XB_SLEEP
#define XB_SLEEP 1
#endif
#define XB_SPIN(cond, bar) do { unsigned _sp = 0; while (cond) { if (XB_SLEEP) __builtin_amdgcn_s_sleep(1); \
    if ((++_sp & 255u) == 0u) { if (xb_ld(&(bar)[XB_TMO])) break; if (_sp > XB_SPIN_CAP) { atomicAdd(&(bar)[XB_TMO], 1u); break; } } } } while (0)
struct XcdBarrier { unsigned* bar; unsigned x; volatile LAS unsigned* st; };
__device__ __forceinline__ XcdBarrier xcd_barrier_post(unsigned* bar, volatile LAS unsigned* st) {
    XcdBarrier b; b.bar = bar; b.x = xb_xcc_id(); b.st = st;
    if (threadIdx.x == 0) (void)xb_add(&bar[XB_XCNT(b.x)], 1u);
    return b;
}
__device__ __forceinline__ void xcd_barrier_complete(unsigned* bar, unsigned x, unsigned& nloc, unsigned& nx) {
    const unsigned G = gridDim.x * gridDim.y * gridDim.z;
    unsigned sum, cnt, mine, sp = 0u;
    for (;;) {
        sum = 0u; cnt = 0u; mine = 0u;
#pragma unroll
        for (unsigned j = 0; j < 16; ++j) { const unsigned c = xb_ld(&bar[XB_XCNT(j)]); sum += c; cnt += (c > 0u) ? 1u : 0u; mine = (j == x) ? c : mine; }
        if (sum == G) break;
        __builtin_amdgcn_s_sleep(1);
        if ((++sp & 255u) == 0u) { if (xb_ld(&bar[XB_TMO])) break; if (sp > XB_SPIN_CAP) { atomicAdd(&bar[XB_TMO], 1u); break; } }
    }
    nloc = mine > 0u ? mine : 1u; nx = cnt > 0u ? cnt : 1u;
}
__device__ __forceinline__ void xcd_barrier(const XcdBarrier& b) {
    asm volatile("s_waitcnt vmcnt(0)" ::: "memory");
    __syncthreads();
    if (threadIdx.x == 0) {
        unsigned* bar = b.bar;
        __builtin_amdgcn_s_waitcnt(0);
        unsigned nloc = b.st[0], nx = b.st[1];
        if (nloc == 0u) { xcd_barrier_complete(bar, b.x, nloc, nx); b.st[0] = nloc; b.st[1] = nx; }
        const unsigned old = xb_add(&bar[XB_XSUB(b.x)], 1u);
        const unsigned gen = old / nloc;
        if (old + 1u == (gen + 1u) * nloc) {
            __builtin_amdgcn_fence(__ATOMIC_RELEASE, "agent");
            asm volatile("s_waitcnt vmcnt(0)" ::: "memory");
            const unsigned og = xb_add(&bar[XB_TOP], 1u);
            const unsigned tg = og / nx;
            if (og + 1u == (tg + 1u) * nx) xb_add(&bar[XB_TOPGEN], 1u);
            else XB_SPIN(xb_ld(&bar[XB_TOPGEN]) == tg, bar);
            __builtin_amdgcn_fence(__ATOMIC_ACQUIRE, "agent");
            xb_add(&bar[XB_XGEN(b.x)], 1u);
            asm volatile("s_waitcnt vmcnt(0)" ::: "memory");
        } else {
            XB_SPIN(xb_ld(&bar[XB_XGEN(b.x)]) == gen, bar);
            __builtin_amdgcn_fence(__ATOMIC_ACQUIRE, "agent");
            asm volatile("s_waitcnt vmcnt(0)" ::: "memory");
        }
    }
    __syncthreads();
}

namespace pg8 {
constexpr int BM = 256, BK = 64, HALF = 128, HTB = HALF * BK * 2, STAGE_BYTES = 8 * HTB, NXCD = 8, WGM = 8;
__host__ __device__ __forceinline__ int lds_byte(int r, int c) { const int st = (r >> 4) * 2 + (c >> 5), rr = r & 15, cc = c & 31, ob = rr * 64 + cc * 2; return st * 1024 + (ob ^ (((ob >> 9) & 1) << 5)); }
__host__ __device__ __forceinline__ void stage_rc(int b, int& R, int& C) { const int st = b / 1024, sb = b % 1024, swz = sb ^ (((sb >> 9) & 1) << 5); R = (st >> 1) * 16 + swz / 64; C = (st & 1) * 32 + (swz % 64) / 2; }
__host__ __device__ __forceinline__ int perm32(int rho) { const int n = rho >> 4, i = rho & 15; return 8 * (i >> 2) + 4 * n + (i & 3); }

struct Unit { const char* A; const char* B; int pm, pn, z; };
struct Gemm { int lda, ldb, K; };

__device__ __forceinline__ void static_map(int L, int nM, int nN, int& pm, int& pn) {
    const int nwg = nM * nN; int wgid = L;
    { const int q = nwg / NXCD, r = nwg % NXCD, xcd = wgid % NXCD, off = wgid / NXCD; wgid = (xcd < r ? xcd * (q + 1) : r * (q + 1) + (xcd - r) * q) + off; }
    const int nig = WGM * nN, gid = wgid / nig, fm = gid * WGM, gsz = (nM - fm) < WGM ? (nM - fm) : WGM;
    pm = fm + ((wgid % nig) % gsz); pn = (wgid % nig) / gsz;
}

template <class Epi, class Sched>
__device__ __forceinline__ void gemm_phase(LAS unsigned char* lds, const Gemm g, const Sched& S, const Epi& E) {
#ifndef PG8_ALIGN
#define PG8_ALIGN true
#endif
    constexpr bool ALIGN_EPI = PG8_ALIGN;
    int tid = threadIdx.x; asm volatile("" : "+v"(tid));
    const int wid = __builtin_amdgcn_readfirstlane(tid >> 6), lane = tid & 63, wr = wid >> 2, wc = wid & 3, fr = lane & 15, fq = lane >> 4;
    int K = g.K; asm volatile("" : "+s"(K));
    const int nt = K / BK;
    unsigned voffA[2], voffB[2];
#pragma unroll
    for (int i = 0; i < 2; ++i) { int R, C; stage_rc(tid * 16 + i * 8192, R, C); const int Rb = Epi::PERM ? ((R & ~31) + perm32(R & 31)) : R;
        voffA[i] = (unsigned)(R * g.lda + C) * 2u; voffB[i] = (unsigned)(Rb * g.ldb + C) * 2u; }
    const size_t kstep = (size_t)(BK * 2);
    const size_t hstepA = (size_t)HALF * g.lda * 2, hstepB = (size_t)HALF * g.ldb * 2;
    const unsigned ldsw = (unsigned)wid * 1024u;
    const int aoff = lds_byte(wr * 64 + fr, fq * 8), boff = lds_byte(wc * 32 + fr, fq * 8);
#define PG8_SA(b, h) (((b) * 2 + (h)) * HTB)
#define PG8_SB(b, h) ((4 + (b) * 2 + (h)) * HTB)
#define PG8_STAGE(bufoff, gbase, voff) do { _Pragma("unroll") for (int _i = 0; _i < 2; ++_i) \
        __builtin_amdgcn_global_load_lds((const unsigned*)((const char*)(gbase) + (voff)[_i]), (LAS unsigned*)(lds + (bufoff) + ldsw + _i * 8192), 16, 0, 0); } while (0)
#define PG8_LDA(dst, b, h) do { _Pragma("unroll") for (int m = 0; m < 4; ++m) _Pragma("unroll") for (int k = 0; k < 2; ++k) dst[m][k] = *(const LAS bf16x8*)(lds + PG8_SA(b, h) + aoff + m * 2048 + k * 1024); } while (0)
#define PG8_LDB(dst, b, h) do { _Pragma("unroll") for (int n = 0; n < 2; ++n) _Pragma("unroll") for (int k = 0; k < 2; ++k) dst[n][k] = *(const LAS bf16x8*)(lds + PG8_SB(b, h) + boff + n * 2048 + k * 1024); } while (0)
#define PG8_MMA(ai, bj, At, Bt) do { __builtin_amdgcn_s_setprio(1); _Pragma("unroll") for (int m = 0; m < 4; ++m) _Pragma("unroll") for (int n = 0; n < 2; ++n) _Pragma("unroll") for (int k = 0; k < 2; ++k) \
        acc[ai][bj][m][n] = __builtin_amdgcn_mfma_f32_16x16x32_bf16(Bt[n][k], At[m][k], acc[ai][bj][m][n], 0, 0, 0); __builtin_amdgcn_s_setprio(0); } while (0)
#define PG8_WAIT_V(n) asm volatile("s_waitcnt vmcnt(" #n ")" ::: "memory")
#define PG8_WAIT_L(n) asm volatile("s_waitcnt lgkmcnt(" #n ")" ::: "memory")
#define PG8_BAR __builtin_amdgcn_s_barrier()
#define PG8_SCHED __builtin_amdgcn_sched_barrier(0)
    Unit cur, nxt; int ui = 0;
    if (!S.next(0, cur)) return;
    f32x4 acc[2][2][4][2];
#pragma unroll
    for (int a = 0; a < 2; ++a)
#pragma unroll
        for (int b = 0; b < 2; ++b)
#pragma unroll
            for (int m = 0; m < 4; ++m)
#pragma unroll
                for (int n = 0; n < 2; ++n) acc[a][b][m][n] = (f32x4){0.f, 0.f, 0.f, 0.f};
    bf16x8 At[4][2], B0[2][2], B1[2][2];
    const char* cA = cur.A; const char* cB = cur.B;
    PG8_STAGE(PG8_SB(0, 0), cB, voffB); PG8_STAGE(PG8_SB(0, 1), cB + hstepB, voffB); PG8_STAGE(PG8_SA(0, 0), cA, voffA); PG8_STAGE(PG8_SA(0, 1), cA + hstepA, voffA);
    if (wr == 1) PG8_BAR;
    PG8_WAIT_V(2); PG8_BAR;
    PG8_STAGE(PG8_SB(1, 0), cB + kstep, voffB); PG8_STAGE(PG8_SA(1, 0), cA + kstep, voffA); PG8_STAGE(PG8_SB(1, 1), cB + hstepB + kstep, voffB);
    PG8_WAIT_V(6); PG8_BAR;
    for (;;) {
        const bool has_next = S.next(ui + 1, nxt);
        const char* nA = has_next ? nxt.A : cA; const char* nB = has_next ? nxt.B : cB;
        for (int t = 0; t < nt; t += 2) {
            const bool last = (t == nt - 2);
            const char* a1 = cA + (size_t)(t + 1) * kstep;
            const char* a2 = last ? nA : cA + (size_t)(t + 2) * kstep; const char* b2 = last ? nB : cB + (size_t)(t + 2) * kstep;
            const char* a3 = a2 + kstep; const char* b3 = b2 + kstep;
            PG8_LDB(B0, 0, 0); PG8_LDB(B1, 0, 1); PG8_SCHED; PG8_LDA(At, 0, 0); PG8_STAGE(PG8_SA(1, 1), a1 + hstepA, voffA);
            PG8_WAIT_V(8); PG8_WAIT_L(0); PG8_BAR; PG8_MMA(0, 0, At, B0); PG8_MMA(0, 1, At, B1); PG8_BAR; PG8_SCHED;
            PG8_LDA(At, 0, 1); PG8_STAGE(PG8_SB(0, 0), b2, voffB); PG8_STAGE(PG8_SB(0, 1), b2 + hstepB, voffB); PG8_STAGE(PG8_SA(0, 0), a2, voffA);
            PG8_WAIT_V(8); PG8_WAIT_L(0); PG8_BAR; PG8_MMA(1, 0, At, B0); PG8_MMA(1, 1, At, B1); PG8_BAR; PG8_SCHED;
            PG8_LDB(B0, 1, 0); PG8_LDB(B1, 1, 1); PG8_SCHED; PG8_LDA(At, 1, 0); PG8_STAGE(PG8_SA(0, 1), a2 + hstepA, voffA);
            PG8_WAIT_V(8); PG8_WAIT_L(0); PG8_BAR; PG8_MMA(0, 0, At, B0); PG8_MMA(0, 1, At, B1); PG8_BAR; PG8_SCHED;
            PG8_LDA(At, 1, 1); PG8_STAGE(PG8_SB(1, 0), b3, voffB); PG8_STAGE(PG8_SB(1, 1), b3 + hstepB, voffB); PG8_STAGE(PG8_SA(1, 0), a3, voffA);
            PG8_WAIT_V(8); PG8_WAIT_L(0); PG8_BAR; PG8_MMA(1, 0, At, B0); PG8_MMA(1, 1, At, B1); PG8_BAR; PG8_SCHED;
        }
        if constexpr (ALIGN_EPI) { if (wr == 0) PG8_BAR; }
        if constexpr (!Epi::AFTER_DRAIN) E(acc, cur, wr, wc, fr, fq);
        if (!has_next) break;
#pragma unroll
        for (int a = 0; a < 2; ++a)
#pragma unroll
            for (int b = 0; b < 2; ++b)
#pragma unroll
                for (int m = 0; m < 4; ++m)
#pragma unroll
                    for (int n = 0; n < 2; ++n) acc[a][b][m][n] = (f32x4){0.f, 0.f, 0.f, 0.f};
        cur = nxt; cA = nA; cB = nB; ++ui;
        if constexpr (ALIGN_EPI) { if (wr == 1) PG8_BAR; }
    }
    PG8_WAIT_V(0);
    if constexpr (!ALIGN_EPI) { if (wr == 0) PG8_BAR; }
    PG8_BAR;
    if constexpr (Epi::AFTER_DRAIN) E.fused(acc, cur, wr, wc, fr, fq);
#undef PG8_SA
#undef PG8_SB
#undef PG8_STAGE
#undef PG8_LDA
#undef PG8_LDB
#undef PG8_MMA
#undef PG8_WAIT_V
#undef PG8_WAIT_L
#undef PG8_BAR
#undef PG8_SCHED
}
}
using pg8::Unit;

struct PlainOrder {
    const char* A; const char* B; size_t tA, tB; int nM, nN, G, c;
    __device__ __forceinline__ bool next(int i, Unit& u) const {
        const int L = i * G + c; if (L >= nM * nN) return false;
        int pm, pn; pg8::static_map(L, nM, nN, pm, pn);
        u.pm = pm; u.pn = pn; u.z = 0; u.A = A + (size_t)pm * tA; u.B = B + (size_t)pn * tB; return true;
    }
};
struct MixInOrder {
    const char* A; const char* B; int G, c, lo, hi;
    __device__ __forceinline__ bool next(int i, Unit& u) const {
        const int L = lo + i * G + c; if (L >= hi) return false;
        int pm, pn;
        if (L < 640) pg8::static_map(L, 64, 10, pm, pn); else { const int e = L - 640; pm = 64 + (e >> 2); pn = 6 + (e & 3); }
        u.pm = pm; u.pn = pn; u.z = 0; u.A = A + (size_t)pm * (256 * D * 2); u.B = B + (size_t)pn * (256 * D * 2); return true;
    }
};
struct CtxSplitOrder {
    const char* A; const char* B; int G, c;
    __device__ __forceinline__ bool next(int i, Unit& u) const {
        const int L = i * G + c; if (L >= 176) return false;
        const int t = L / 11, sp = L - t * 11, pm = t >> 2, pn = t & 3;
        u.pm = pm; u.pn = pn; u.z = sp; u.A = A + ((size_t)(NTOK + pm * 256) * DFF + sp * 256) * 2; u.B = B + ((size_t)(pn * 256) * DFF + sp * 256) * 2; return true;
    }
};
struct DftAOrder {
    const char* A; const char* XN; int G, v;
    __device__ __forceinline__ bool next(int i, Unit& u) const {
        const int L = i * G + v; if (L >= 512) return false;
        const int bg = L >> 5, rem = L & 31, pm = rem >> 4, pn = rem & 15, b = bg >> 2, gr = bg & 3;
        u.pm = pm; u.pn = pn; u.z = bg; u.A = A + (size_t)pm * (256 * 256 * 2); u.B = XN + ((size_t)(b * SEQ + pn * 256) * D + gr * 256) * 2; return true;
    }
};
struct DftBOrder {
    const char* A; const char* T; int G, v;
    __device__ __forceinline__ bool next(int i, Unit& u) const {
        const int L = i * G + v; if (L >= 256) return false;
        const int x = L >> 5, j = L & 31, pm = j & 7, rest = x * 4 + (j >> 3), which = rest & 1, bg = rest >> 1;
        u.pm = pm; u.pn = which; u.z = bg; u.A = A + (size_t)pm * (256 * (size_t)8192 * 2) + (size_t)which * 8192; u.B = T + (size_t)bg * (256 * (size_t)8192 * 2) + (size_t)which * 8192; return true;
    }
};

__device__ __forceinline__ float rstd_of(float ss) { return rsqrtf(ss * (1.0f / D) + 1e-6f); }
struct EpiSwiglu {
    static constexpr bool PERM = true; static constexpr bool AFTER_DRAIN = false;
    unsigned char* ws; int ss_off, cb_off;
    __device__ __forceinline__ void operator()(const f32x4 (&acc)[2][2][4][2], const Unit& u, int wr, int wc, int fr, int fq) const {
        const int row0 = u.pm * 256 + wr * 64 + fr, col0 = u.pn * 128 + wc * 32 + 8 * fq;
        const int mb = u.pm < 64 ? (u.pm >> 4) : 4;
        bf16_t* O = (bf16_t*)(ws + WS_ACT); const float* SSc = (const float*)(ws + WS_SS) + ss_off;
        const float* cbp = (const float*)(ws + WS_CB) + cb_off + (size_t)mb * NFF1 + u.pn * 256 + wc * 32 + 8 * fq;
        const f32x4 cg0 = *(const f32x4*)cbp, cg1 = *(const f32x4*)(cbp + 4), cu0 = *(const f32x4*)(cbp + 128), cu1 = *(const f32x4*)(cbp + 132);
        float rr[2][4];
#pragma unroll
        for (int ai = 0; ai < 2; ++ai)
#pragma unroll
            for (int m = 0; m < 4; ++m) rr[ai][m] = SSc[row0 + ai * 128 + m * 16];
#pragma unroll
        for (int ai = 0; ai < 2; ++ai)
#pragma unroll
            for (int m = 0; m < 4; ++m) {
                const int row = row0 + ai * 128 + m * 16;
                const float r = rstd_of(rr[ai][m]);
                bf16_t* rowp = O + (size_t)row * DFF + col0;
                const f32x4 g0 = acc[ai][0][m][0] * r + cg0, g1 = acc[ai][0][m][1] * r + cg1, u0 = acc[ai][1][m][0] * r + cu0, u1 = acc[ai][1][m][1] * r + cu1;
                u32x4 w;
                w.x = cvt_pk_bf16(siluf_(g0[0]) * u0[0], siluf_(g0[1]) * u0[1]); w.y = cvt_pk_bf16(siluf_(g0[2]) * u0[2], siluf_(g0[3]) * u0[3]);
                w.z = cvt_pk_bf16(siluf_(g1[0]) * u1[0], siluf_(g1[1]) * u1[1]); w.w = cvt_pk_bf16(siluf_(g1[2]) * u1[2], siluf_(g1[3]) * u1[3]);
                ST16(0, rowp, w);
            }
    }
};
template <bool FUSE, bool INPLACE, bool HASBIAS> struct EpiResid {
    static constexpr bool PERM = true; static constexpr bool AFTER_DRAIN = false;
    unsigned char* ws; const float* base0; const float* base1; const float* bias; float gmul; int gate_off, ss_off, gn_off, scn_off;
    __device__ __forceinline__ void operator()(const f32x4 (&acc)[2][2][4][2], const Unit& u, int wr, int wc, int fr, int fq) const {
        const int row0 = u.pm * 256 + wr * 64 + fr, col0 = u.pn * 256 + wc * 32 + 8 * fq;
        const int mb = u.pm < 64 ? (u.pm >> 4) : 4;
        float* SSn = (float*)(ws + WS_SS) + ss_off;
        const float* gate = (const float*)(ws + WS_MOD) + gate_off + (size_t)mb * 9216; const float* gn = (const float*)(ws + WS_NG) + gn_off; const float* scn = (const float*)(ws + WS_MOD) + scn_off + (size_t)mb * 9216;
        f32x4 gv[2][2], bv[2][2], wv[2][2];
#pragma unroll
        for (int bj = 0; bj < 2; ++bj)
#pragma unroll
            for (int n = 0; n < 2; ++n) { const int cc = col0 + bj * 128 + 4 * n;
                gv[bj][n] = *(const f32x4*)(gate + cc) * gmul;
                bv[bj][n] = HASBIAS ? *(const f32x4*)(bias + cc) : (f32x4){0.f, 0.f, 0.f, 0.f};
                wv[bj][n] = FUSE ? *(const f32x4*)(gn + cc) * (*(const f32x4*)(scn + cc) + 1.0f) : (f32x4){0.f, 0.f, 0.f, 0.f}; }
        const unsigned e0 = (unsigned)(row0 * D + col0);
        const char* bsc = (const char*)base0; char* Hc = (char*)(ws + WS_H); char* HBc = (char*)(ws + WS_XN);
        constexpr int RGB = 2;
#pragma unroll
        for (int rg = 0; rg < 8 / RGB; ++rg) {
            u32x4 braw[INPLACE ? RGB : 1][2]; f32x4 bb[INPLACE ? 1 : RGB][2][2];
#pragma unroll
            for (int mm = 0; mm < RGB; ++mm) { const int q = rg * RGB + mm, ai = q >> 2, m = q & 3;
#pragma unroll
                for (int bj = 0; bj < 2; ++bj) { const unsigned e = e0 + (unsigned)((ai * 128 + m * 16) * D + bj * 128);
                    if constexpr (INPLACE) braw[mm][bj] = *(const u32x4*)(Hc + (size_t)(e * 2u));
                    else { bb[mm][bj][0] = *(const f32x4*)(bsc + (size_t)(e * 4u)); bb[mm][bj][1] = *(const f32x4*)(bsc + (size_t)(e * 4u + 16u)); } } }
#pragma unroll
            for (int mm = 0; mm < RGB; ++mm) { const int q = rg * RGB + mm, ai = q >> 2, m = q & 3; float ssum = 0.f;
#pragma unroll
                for (int bj = 0; bj < 2; ++bj) { const unsigned e = e0 + (unsigned)((ai * 128 + m * 16) * D + bj * 128);
                    f32x4 r0, r1;
                    if constexpr (INPLACE) { const u32x4 q4 = braw[mm][bj];
                        r0 = (f32x4){__uint_as_float(q4[0] << 16), __uint_as_float(q4[0] & 0xffff0000u), __uint_as_float(q4[1] << 16), __uint_as_float(q4[1] & 0xffff0000u)};
                        r1 = (f32x4){__uint_as_float(q4[2] << 16), __uint_as_float(q4[2] & 0xffff0000u), __uint_as_float(q4[3] << 16), __uint_as_float(q4[3] & 0xffff0000u)}; }
                    else { r0 = bb[mm][bj][0]; r1 = bb[mm][bj][1]; }
                    const f32x4 h0 = r0 + gv[bj][0] * (acc[ai][bj][m][0] + bv[bj][0]), h1 = r1 + gv[bj][1] * (acc[ai][bj][m][1] + bv[bj][1]);
                    { u32x4 w; w.x = cvt_pk_bf16(h0[0], h0[1]); w.y = cvt_pk_bf16(h0[2], h0[3]); w.z = cvt_pk_bf16(h1[0], h1[1]); w.w = cvt_pk_bf16(h1[2], h1[3]); ST16(1, Hc + (size_t)(e * 2u), w); }
                    if (FUSE) { ssum += ((h0[0] * h0[0] + h0[1] * h0[1]) + (h0[2] * h0[2] + h0[3] * h0[3])) + ((h1[0] * h1[0] + h1[1] * h1[1]) + (h1[2] * h1[2] + h1[3] * h1[3]));
                        const f32x4 z0 = h0 * wv[bj][0], z1 = h1 * wv[bj][1];
                        u32x4 w; w.x = cvt_pk_bf16(z0[0], z0[1]); w.y = cvt_pk_bf16(z0[2], z0[3]); w.z = cvt_pk_bf16(z1[0], z1[1]); w.w = cvt_pk_bf16(z1[2], z1[3]);
                        ST16(2, HBc + (size_t)(e * 2u), w); } }
                if (FUSE) { ssum += __shfl_xor(ssum, 16); ssum += __shfl_xor(ssum, 32); if (fq == 0) unsafeAtomicAdd(SSn + (unsigned)(row0 + ai * 128 + m * 16), ssum); } }
            asm volatile("" ::: "memory"); }
    }
};
struct EpiFinal {
    static constexpr bool PERM = true; static constexpr bool AFTER_DRAIN = true;
    unsigned char* ws; float* out; const float* fg; int gate_off;
    __device__ __forceinline__ void fused(f32x4 (&acc)[2][2][4][2], const Unit& u, int wr, int wc, int fr, int fq) const {
        const int row0 = u.pm * 256 + wr * 64 + fr, col0 = u.pn * 256 + wc * 32 + 8 * fq;
        const int mb = u.pm >> 4;
        const char* Hc = (const char*)(ws + WS_H); float* SSF = (float*)(ws + WS_SSF); unsigned* cnt = (unsigned*)(ws + WS_CNTF) + 64 * u.pm;
        const float* gate = (const float*)(ws + WS_MOD) + gate_off + (size_t)mb * 9216;
        const unsigned e0 = (unsigned)(row0 * D + col0);
        {
            f32x4 gv[2][2];
#pragma unroll
            for (int bj = 0; bj < 2; ++bj)
#pragma unroll
                for (int n = 0; n < 2; ++n) gv[bj][n] = *(const f32x4*)(gate + col0 + bj * 128 + 4 * n) * 0.5f;
#pragma unroll
            for (int rg = 0; rg < 4; ++rg) {
                u32x4 braw[2][2];
#pragma unroll
                for (int mm = 0; mm < 2; ++mm) { const int q = rg * 2 + mm, ai = q >> 2, m = q & 3;
#pragma unroll
                    for (int bj = 0; bj < 2; ++bj) { const unsigned e = e0 + (unsigned)((ai * 128 + m * 16) * D + bj * 128); braw[mm][bj] = *(const u32x4*)(Hc + (size_t)(e * 2u)); } }
#pragma unroll
                for (int mm = 0; mm < 2; ++mm) { const int q = rg * 2 + mm, ai = q >> 2, m = q & 3; float ssum = 0.f;
#pragma unroll
                    for (int bj = 0; bj < 2; ++bj) { const u32x4 q4 = braw[mm][bj];
                        const f32x4 r0 = (f32x4){__uint_as_float(q4[0] << 16), __uint_as_float(q4[0] & 0xffff0000u), __uint_as_float(q4[1] << 16), __uint_as_float(q4[1] & 0xffff0000u)};
                        const f32x4 r1 = (f32x4){__uint_as_float(q4[2] << 16), __uint_as_float(q4[2] & 0xffff0000u), __uint_as_float(q4[3] << 16), __uint_as_float(q4[3] & 0xffff0000u)};
                        const f32x4 h0 = r0 + gv[bj][0] * acc[ai][bj][m][0], h1 = r1 + gv[bj][1] * acc[ai][bj][m][1]; acc[ai][bj][m][0] = h0; acc[ai][bj][m][1] = h1;
                        ssum += ((h0[0] * h0[0] + h0[1] * h0[1]) + (h0[2] * h0[2] + h0[3] * h0[3])) + ((h1[0] * h1[0] + h1[1] * h1[1]) + (h1[2] * h1[2] + h1[3] * h1[3])); }
                    ssum += __shfl_xor(ssum, 16); ssum += __shfl_xor(ssum, 32);
                    if (fq == 0) unsafeAtomicAdd(SSF + (unsigned)(row0 + ai * 128 + m * 16), ssum); }
                asm volatile("" ::: "memory"); }
        }
        asm volatile("s_waitcnt vmcnt(0)" ::: "memory");
        if ((threadIdx.x & 63) == 0) __hip_atomic_fetch_add(cnt, 1u, __ATOMIC_RELAXED, __HIP_MEMORY_SCOPE_AGENT);
        { unsigned spins = 0;
          while ((unsigned)__builtin_amdgcn_readfirstlane(__hip_atomic_load(cnt, __ATOMIC_RELAXED, __HIP_MEMORY_SCOPE_AGENT)) < 32u) { __builtin_amdgcn_s_sleep(2); if (++spins > (1u << 22)) break; } }
        float rr[2][4];
#pragma unroll
        for (int ai = 0; ai < 2; ++ai)
#pragma unroll
            for (int m = 0; m < 4; ++m) rr[ai][m] = rstd_of(__hip_atomic_load(SSF + (unsigned)(row0 + ai * 128 + m * 16), __ATOMIC_RELAXED, __HIP_MEMORY_SCOPE_AGENT));
        f32x4 fv[2][2];
#pragma unroll
        for (int bj = 0; bj < 2; ++bj)
#pragma unroll
            for (int n = 0; n < 2; ++n) fv[bj][n] = *(const f32x4*)(fg + col0 + bj * 128 + 4 * n);
#pragma unroll
        for (int ai = 0; ai < 2; ++ai)
#pragma unroll
            for (int m = 0; m < 4; ++m)
#pragma unroll
                for (int bj = 0; bj < 2; ++bj) { const unsigned e = e0 + (unsigned)((ai * 128 + m * 16) * D + bj * 128);
                    *(f32x4*)((char*)out + (size_t)(e * 4u)) = acc[ai][bj][m][0] * rr[ai][m] * fv[bj][0]; *(f32x4*)((char*)out + (size_t)(e * 4u + 16u)) = acc[ai][bj][m][1] * rr[ai][m] * fv[bj][1]; }
    }
    __device__ __forceinline__ void operator()(const f32x4 (&)[2][2][4][2], const Unit&, int, int, int, int) const {}
};
struct EpiCtxAtomic {
    static constexpr bool PERM = false; static constexpr bool AFTER_DRAIN = false;
    float* H; const float* gate; float gmul;
    __device__ __forceinline__ void operator()(const f32x4 (&acc)[2][2][4][2], const Unit& u, int wr, int wc, int fr, int fq) const {
        const int row0 = u.pm * 256 + wr * 64 + fr, col0 = u.pn * 256 + wc * 32 + 4 * fq;
#pragma unroll
        for (int bj = 0; bj < 2; ++bj)
#pragma unroll
            for (int n = 0; n < 2; ++n) { const f32x4 gv = *(const f32x4*)(gate + col0 + bj * 128 + n * 16) * gmul;
#pragma unroll
                for (int ai = 0; ai < 2; ++ai)
#pragma unroll
                    for (int m = 0; m < 4; ++m) { float* o = H + (size_t)(row0 + ai * 128 + m * 16) * D + col0 + bj * 128 + n * 16; const f32x4 v = gv * acc[ai][bj][m][n];
#pragma unroll
                        for (int i = 0; i < 4; ++i) unsafeAtomicAdd(o + i, v[i]); } }
    }
};
struct EpiMixIn {
    static constexpr bool PERM = true; static constexpr bool AFTER_DRAIN = false;
    unsigned char* ws; int ss_off;
    __device__ __forceinline__ void operator()(const f32x4 (&accr)[2][2][4][2], const Unit& u, int wr, int wc, int fr, int fq) const {
        const int row0 = u.pm * 256 + wr * 64 + fr;
        f32x4 acc[2][2][4][2];
        bf16_t *YG = (bf16_t*)(ws + WS_YG), *QB = (bf16_t*)(ws + WS_QB), *KB = (bf16_t*)(ws + WS_KB), *VTL = (bf16_t*)(ws + WS_VTL), *VTC = (bf16_t*)(ws + WS_VTC);
        const float* SSc = (const float*)(ws + WS_SS) + ss_off;
        { const int mb = u.pm < 64 ? (u.pm >> 4) : 4; const float* cbp = (const float*)(ws + WS_CBAB) + (size_t)mb * NAB + u.pn * 256 + wc * 32 + 8 * fq;
          f32x4 cv[2][2];
#pragma unroll
          for (int bj = 0; bj < 2; ++bj)
#pragma unroll
              for (int n = 0; n < 2; ++n) cv[bj][n] = *(const f32x4*)(cbp + bj * 128 + 4 * n);
#pragma unroll
          for (int ai = 0; ai < 2; ++ai)
#pragma unroll
              for (int m = 0; m < 4; ++m) { const float r = rstd_of(SSc[row0 + ai * 128 + m * 16]);
#pragma unroll
                  for (int bj = 0; bj < 2; ++bj)
#pragma unroll
                      for (int n = 0; n < 2; ++n) acc[ai][bj][m][n] = accr[ai][bj][m][n] * r + cv[bj][n]; } }
        if (u.pn < 4) {
            const int col0 = u.pn * 128 + wc * 32 + 8 * fq;
#pragma unroll
            for (int ai = 0; ai < 2; ++ai)
#pragma unroll
                for (int m = 0; m < 4; ++m) {
                    const f32x4 a0 = acc[ai][0][m][0], a1 = acc[ai][0][m][1], g0 = acc[ai][1][m][0], g1 = acc[ai][1][m][1];
                    u32x4 w;
                    w.x = cvt_pk_bf16(a0[0] * sigmoidf_(g0[0]), a0[1] * sigmoidf_(g0[1])); w.y = cvt_pk_bf16(a0[2] * sigmoidf_(g0[2]), a0[3] * sigmoidf_(g0[3]));
                    w.z = cvt_pk_bf16(a1[0] * sigmoidf_(g1[0]), a1[1] * sigmoidf_(g1[1])); w.w = cvt_pk_bf16(a1[2] * sigmoidf_(g1[2]), a1[3] * sigmoidf_(g1[3]));
                    ST16(3, YG + (size_t)(row0 + ai * 128 + m * 16) * 512 + col0, w);
                }
        } else if (u.pn < 8) {
            const bool isq = u.pn < 6; bf16_t* O = isq ? QB : KB; const float s = isq ? 0.125f : 1.0f;
            const int col0 = ((u.pn - 4) & 1) * 256 + wc * 32 + 8 * fq;
#pragma unroll
            for (int ai = 0; ai < 2; ++ai)
#pragma unroll
                for (int m = 0; m < 4; ++m)
#pragma unroll
                    for (int bj = 0; bj < 2; ++bj) {
                        const f32x4 v0 = acc[ai][bj][m][0] * s, v1 = acc[ai][bj][m][1] * s;
                        u32x4 w; w.x = cvt_pk_bf16(v0[0], v0[1]); w.y = cvt_pk_bf16(v0[2], v0[3]); w.z = cvt_pk_bf16(v1[0], v1[1]); w.w = cvt_pk_bf16(v1[2], v1[3]);
                        ST16(3, O + (size_t)(row0 + ai * 128 + m * 16) * 512 + col0 + bj * 128, w);
                    }
        } else {
            const int col0 = (u.pn - 8) * 256 + wc * 32 + 8 * fq;
#pragma unroll
            for (int ai = 0; ai < 2; ++ai)
#pragma unroll
                for (int m = 0; m < 4; ++m) {
                    const int row = row0 + ai * 128 + m * 16;
                    bf16_t* base; size_t dstride;
                    if (u.pm < 64) { const int b = row >> 12, n = row & 4095; base = VTL + (size_t)b * (512 * 4096) + n; dstride = 4096; }
                    else { const int rr = row - NTOK, b = rr >> 8, j = rr & 255; base = VTC + (size_t)b * (512 * 256) + j; dstride = 256; }
#pragma unroll
                    for (int bj = 0; bj < 2; ++bj)
#pragma unroll
                        for (int n = 0; n < 2; ++n)
#pragma unroll
                            for (int i = 0; i < 4; ++i) { const int c = col0 + bj * 128 + 4 * n + i;
                                const unsigned pk = cvt_pk_bf16(acc[ai][bj][m][n][i], 0.f);
                                PL2(base + (size_t)c * dstride, pk & 0xffffu); }
                }
        }
    }
};
struct EpiDftA {
    static constexpr bool PERM = true; static constexpr bool AFTER_DRAIN = false;
    unsigned char* ws; int ss_off;
    __device__ __forceinline__ void operator()(const f32x4 (&acc)[2][2][4][2], const Unit& u, int wr, int wc, int fr, int fq) const {
        const int rt0 = wr * 64 + fr, pcol0 = u.pn * 256 + wc * 32 + 8 * fq, col0 = u.pm * 4096 + pcol0;
        const int b = u.z >> 2, gr = u.z & 3;
        const float* SSc = (const float*)(ws + WS_SS) + ss_off; const float* cbd = (const float*)(ws + WS_CBD);
        bf16_t* tb = (bf16_t*)(ws + WS_T) + (size_t)u.z * (256 * (size_t)8192);
        f32x4 rc[2][2];
#pragma unroll
        for (int bj = 0; bj < 2; ++bj)
#pragma unroll
            for (int n = 0; n < 2; ++n) { const f32x4 sv = *(const f32x4*)(SSc + b * SEQ + pcol0 + bj * 128 + 4 * n);
                rc[bj][n] = (f32x4){rstd_of(sv[0]), rstd_of(sv[1]), rstd_of(sv[2]), rstd_of(sv[3])}; }
        float cmv[2][4];
#pragma unroll
        for (int ai = 0; ai < 2; ++ai)
#pragma unroll
            for (int m = 0; m < 4; ++m) cmv[ai][m] = cbd[(b * 4 + gr) * 512 + u.pm * 256 + rt0 + ai * 128 + m * 16];
#pragma unroll
        for (int ai = 0; ai < 2; ++ai)
#pragma unroll
            for (int m = 0; m < 4; ++m) {
                const int rt = rt0 + ai * 128 + m * 16; const float cm = cmv[ai][m];
#pragma unroll
                for (int bj = 0; bj < 2; ++bj) {
                    const f32x4 v0 = acc[ai][bj][m][0] * rc[bj][0] + cm, v1 = acc[ai][bj][m][1] * rc[bj][1] + cm;
                    u32x4 w; w.x = cvt_pk_bf16(v0[0], v0[1]); w.y = cvt_pk_bf16(v0[2], v0[3]); w.z = cvt_pk_bf16(v1[0], v1[1]); w.w = cvt_pk_bf16(v1[2], v1[3]);
                    ST16(4, tb + (size_t)rt * 8192 + col0 + bj * 128, w);
                } }
    }
};
typedef __amdgpu_buffer_rsrc_t rsrc_t;
struct EpiDftX {
    static constexpr bool PERM = true; static constexpr bool AFTER_DRAIN = true;
    unsigned char* ws;
    __device__ __forceinline__ void operator()(const f32x4 (&)[2][2][4][2], const Unit&, int, int, int, int) const {}
    __device__ __forceinline__ void fused(f32x4 (&acc)[2][2][4][2], const Unit& u, int wr, int wc, int fr, int fq) const {
        const int which = u.pn, bg = u.z, b = bg >> 2, gr = bg & 3, lane = threadIdx.x & 63, wave = threadIdx.x >> 6;
        const int row0 = u.pm * 256 + wr * 64 + fr, col0 = wc * 32 + 8 * fq;
        const rsrc_t rs = __builtin_amdgcn_make_buffer_rsrc((void*)ws, (short)0, (int)WS_TOTAL, 0x00020000);
        const unsigned own = (unsigned)(WS_XN + (size_t)(which * 16 + bg) * (2048 * 256) * 2), par = (unsigned)(WS_XN + (size_t)((1 - which) * 16 + bg) * (2048 * 256) * 2);
#pragma unroll
        for (int ai = 0; ai < 2; ++ai)
#pragma unroll
            for (int m = 0; m < 4; ++m)
#pragma unroll
                for (int bj = 0; bj < 2; ++bj) {
                    const f32x4 v0 = acc[ai][bj][m][0], v1 = acc[ai][bj][m][1];
                    u32x4 w; w.x = cvt_pk_bf16(v0[0], v0[1]); w.y = cvt_pk_bf16(v0[2], v0[3]); w.z = cvt_pk_bf16(v1[0], v1[1]); w.w = cvt_pk_bf16(v1[2], v1[3]);
                    __builtin_amdgcn_raw_buffer_store_b128(w, rs, own + (unsigned)(((row0 + ai * 128 + m * 16) * 256 + col0 + bj * 128) * 2), 0, 16);
                }
        asm volatile("s_waitcnt vmcnt(0)" ::: "memory");
        unsigned* cnt = (unsigned*)(ws + WS_CNTX) + 64 * (bg * 8 + u.pm);
        if (lane == 0) __hip_atomic_fetch_add(cnt, 1u, __ATOMIC_RELAXED, __HIP_MEMORY_SCOPE_AGENT);
        { unsigned spins = 0;
          while ((unsigned)__builtin_amdgcn_readfirstlane(__hip_atomic_load(cnt, __ATOMIC_RELAXED, __HIP_MEMORY_SCOPE_AGENT)) < 16u) { __builtin_amdgcn_s_sleep(2); if (++spins > (1u << 22)) break; } }
        bf16_t* F = (bf16_t*)(ws + WS_F);
#pragma unroll
        for (int ai = 0; ai < 2; ++ai)
#pragma unroll
            for (int m = 0; m < 4; ++m) {
                const int k = row0 + ai * 128 + m * 16, rout = which ? (SEQ - k) : k;
#pragma unroll
                for (int bj = 0; bj < 2; ++bj) {
                    const u32x4 pv = __builtin_amdgcn_raw_buffer_load_b128(rs, par + (unsigned)((k * 256 + col0 + bj * 128) * 2), 0, 16);
                    const f32x4 a0 = acc[ai][bj][m][0], a1 = acc[ai][bj][m][1];
                    const f32x4 p0 = (f32x4){__uint_as_float(pv[0] << 16), __uint_as_float(pv[0] & 0xffff0000u), __uint_as_float(pv[1] << 16), __uint_as_float(pv[1] & 0xffff0000u)};
                    const f32x4 p1 = (f32x4){__uint_as_float(pv[2] << 16), __uint_as_float(pv[2] & 0xffff0000u), __uint_as_float(pv[3] << 16), __uint_as_float(pv[3] & 0xffff0000u)};
                    const f32x4 o0 = which ? (p0 - a0) : (a0 + p0), o1 = which ? (p1 - a1) : (a1 + p1);
                    u32x4 w; w.x = cvt_pk_bf16(o0[0], o0[1]); w.y = cvt_pk_bf16(o0[2], o0[3]); w.z = cvt_pk_bf16(o1[0], o1[1]); w.w = cvt_pk_bf16(o1[2], o1[3]);
                    if (!(which && k == 0)) ST16(5, F + ((size_t)b * SEQ + rout) * D + gr * 256 + col0 + bj * 128, w);
                } }
        const bf16_t* T = (const bf16_t*)(ws + WS_T);
#pragma unroll
        for (int t = 0; t < 2; ++t) {
            const int m = (which * 8 + u.pm) * 16 + wave * 2 + t;
            const bf16_t* tp = T + ((size_t)bg * 256 + m) * 8192 + lane * 64;
            float sacc = 0.f;
#pragma unroll
            for (int j = 0; j < 8; ++j) { const u32x4 v = *(const u32x4*)(tp + 8 * j);
#pragma unroll
                for (int e = 0; e < 4; ++e) sacc += __uint_as_float(v[e] << 16) - __uint_as_float(v[e] & 0xffff0000u); }
            sacc = wave_sum(sacc) * 0.015625f;
            if (lane == 0) F[((size_t)b * SEQ + 2048) * D + gr * 256 + m] = (bf16_t)(cvt_pk_bf16(sacc, 0.f) & 0xffffu);
        }
    }
};

struct Params { const float* in[19]; float* out; unsigned char* ws; };
enum { I_X = 0, I_C, I_CTX, I_CCTX, I_ADAW, I_ADAB, I_NORMG, I_FFNWIN, I_FFNWOUT, I_ABWIN, I_CONVW, I_CONVB, I_CONVLNG, I_CONVLNB, I_RPB, I_ABWOUT, I_FNETW, I_FNETB, I_FINALG };

__device__ __forceinline__ void transpose_item(const float* W, int K, int N, bf16_t* WT, int n0src, int n0dst, int k0, LAS float* scr, int lane) {
    float v[32];
#pragma unroll
    for (int i = 0; i < 32; ++i) { const int kk = 2 * i + (lane >> 5); v[i] = W[(size_t)(k0 + kk) * N + n0src + (lane & 31)]; }
#pragma unroll
    for (int i = 0; i < 32; ++i) { const int kk = 2 * i + (lane >> 5); scr[kk * 33 + (lane & 31)] = v[i]; }
    asm volatile("s_waitcnt lgkmcnt(0)" ::: "memory");
    const int c = lane & 7;
#pragma unroll
    for (int j = 0; j < 4; ++j) { const int n = (lane >> 3) + 8 * j; const LAS float* s = scr + (8 * c) * 33 + n;
        u32x4 o; o.x = cvt_pk_bf16(s[0 * 33], s[1 * 33]); o.y = cvt_pk_bf16(s[2 * 33], s[3 * 33]); o.z = cvt_pk_bf16(s[4 * 33], s[5 * 33]); o.w = cvt_pk_bf16(s[6 * 33], s[7 * 33]);
        ST16(6, WT + (size_t)(n0dst + n) * K + k0 + 8 * c, o); }
    asm volatile("s_waitcnt lgkmcnt(0)" ::: "memory");
}
__device__ __forceinline__ int paired_src(int n0d, int Hs) { const int t = n0d >> 8, cp = n0d & 255; return cp < 128 ? t * 128 + cp : Hs + t * 128 + (cp - 128); }

__device__ __forceinline__ void gen_dftl(unsigned char* ws, LAS unsigned char* lds, int first) {
    const int tid = threadIdx.x, lane = tid & 63, wave = tid >> 6, nb = (int)gridDim.x - first, bi = (int)blockIdx.x - first;
    if (bi < 0) return;
    LAS float* lut = (LAS float*)lds;
    for (int i = tid; i < 4096; i += 512) lut[i] = cospif((float)i * (1.0f / 2048.0f));
    __syncthreads();
    bf16_t* DL = (bf16_t*)(ws + WS_DFTL);
    for (int k = bi * 8 + wave; k < 2048; k += nb * 8) {
        float cj[8], sj[8];
#pragma unroll
        for (int j = 0; j < 8; ++j) { const int idx = (k * j) & 4095; cj[j] = lut[idx] * 0.015625f; sj[j] = lut[(idx - 1024) & 4095] * 0.015625f; }
#pragma unroll
        for (int i = 0; i < 8; ++i) { const int n0 = 8 * (lane + 64 * i), idx0 = (k * n0) & 4095; const float c0 = lut[idx0], s0 = lut[(idx0 - 1024) & 4095]; float vc[8], vs[8];
#pragma unroll
            for (int j = 0; j < 8; ++j) { vc[j] = c0 * cj[j] - s0 * sj[j]; vs[j] = s0 * cj[j] + c0 * sj[j]; }
            u32x4 o; o.x = cvt_pk_bf16(vc[0], vc[1]); o.y = cvt_pk_bf16(vc[2], vc[3]); o.z = cvt_pk_bf16(vc[4], vc[5]); o.w = cvt_pk_bf16(vc[6], vc[7]);
            ST16(6, DL + (size_t)k * 8192 + n0, o);
            o.x = cvt_pk_bf16(vs[0], vs[1]); o.y = cvt_pk_bf16(vs[2], vs[3]); o.z = cvt_pk_bf16(vs[4], vs[5]); o.w = cvt_pk_bf16(vs[6], vs[7]);
            ST16(6, DL + (size_t)k * 8192 + 4096 + n0, o); }
    }
    __syncthreads();
}

__device__ __forceinline__ void prologue(const Params& p, LAS unsigned char* lds) {
    const int tid = threadIdx.x, lane = tid & 63, wave = tid >> 6, G = gridDim.x;
    unsigned char* ws = p.ws;
    {
        LAS float* sil = (LAS float*)lds;
        LAS float* part = (LAS float*)(lds + 20480);
        for (int i = tid; i < 5 * 1024; i += 512) { const int b = i >> 10, k = i & 1023; const float v = (b < 4) ? p.in[I_C][b * 1024 + k] : p.in[I_CCTX][k]; sil[i] = v / (1.0f + __expf(-v)); }
        __syncthreads();
        float* MOD = (float*)(ws + WS_MOD);
        const int cl = tid & 7, kr = tid >> 3;
        for (int item = blockIdx.x; item < 576; item += G) {
            const int l = item / 288, n0 = (item % 288) * 32;
            const float* wp = p.in[I_ADAW] + (size_t)l * 1024 * 9216 + n0 + 4 * cl;
            f32x4 acc[5];
#pragma unroll
            for (int b = 0; b < 5; ++b) acc[b] = (f32x4){0.f, 0.f, 0.f, 0.f};
#pragma unroll
            for (int s = 0; s < 16; ++s) { const int k = kr + 64 * s; const f32x4 w4 = *(const f32x4*)(wp + (size_t)k * 9216);
#pragma unroll
                for (int b = 0; b < 5; ++b) acc[b] += w4 * sil[b * 1024 + k]; }
#pragma unroll
            for (int b = 0; b < 5; ++b)
#pragma unroll
                for (int q = 0; q < 4; ++q) { float v = acc[b][q]; v += __shfl_xor(v, 8); v += __shfl_xor(v, 16); v += __shfl_xor(v, 32); acc[b][q] = v; }
            if (lane < 8) {
#pragma unroll
                for (int b = 0; b < 5; ++b)
#pragma unroll
                    for (int q = 0; q < 4; ++q) part[(wave * 5 + b) * 32 + 4 * lane + q] = acc[b][q];
            }
            __syncthreads();
            if (tid < 160) { const int b = tid >> 5, col = tid & 31; float s = p.in[I_ADAB][l * 9216 + n0 + col];
#pragma unroll
                for (int w = 0; w < 8; ++w) s += part[(w * 5 + b) * 32 + col];
                MOD[(size_t)(l * 5 + b) * 9216 + n0 + col] = s; }
            __syncthreads();
        }
    }
    __syncthreads();
    {
        LAS float* scr = (LAS float*)(lds + wave * 16384);
        const int gw = blockIdx.x * 8 + wave, NGW = G * 8;
        constexpr int I_W1 = 16 * 176, I_W2 = 44 * 32, I_AB = 16 * 80, I_SQ = 16 * 32;
        constexpr int NITEMS = 4 * I_W1 + 4 * I_W2 + I_AB + 2 * I_SQ;
        for (int it = gw; it < NITEMS; it += NGW) {
            int r = it;
            if (r < 4 * I_W1) { const int mi = r / I_W1; r -= mi * I_W1; const int kb = r / 176, nb = r % 176;
                transpose_item(p.in[I_FFNWIN] + (size_t)mi * D * NFF1, D, NFF1, (bf16_t*)(ws + WS_W1T + mi * SZ_W1T), paired_src(nb * 32, DFF), nb * 32, kb * 64, scr, lane); continue; }
            r -= 4 * I_W1;
            if (r < 4 * I_W2) { const int mi = r / I_W2; r -= mi * I_W2; const int kb = r / 32, nb = r % 32;
                transpose_item(p.in[I_FFNWOUT] + (size_t)mi * DFF * D, DFF, D, (bf16_t*)(ws + WS_W2T + mi * SZ_W2T), nb * 32, nb * 32, kb * 64, scr, lane); continue; }
            r -= 4 * I_W2;
            if (r < I_AB) { const int kb = r / 80, nb = r % 80; const int nd = nb * 32, nsrc = nd < 1024 ? paired_src(nd, 512) : nd;
                transpose_item(p.in[I_ABWIN], D, NAB, (bf16_t*)(ws + WS_WABT), nsrc, nd, kb * 64, scr, lane); continue; }
            r -= I_AB;
            if (r < I_SQ) { const int kb = r / 32, nb = r % 32; transpose_item(p.in[I_ABWOUT], D, D, (bf16_t*)(ws + WS_WOT), nb * 32, nb * 32, kb * 64, scr, lane); continue; }
            r -= I_SQ;
            { const int kb = r / 32, nb = r % 32; transpose_item(p.in[I_FNETW], D, D, (bf16_t*)(ws + WS_WFT), nb * 32, nb * 32, kb * 64, scr, lane); }
        }
    }
    __syncthreads();
    {
        LAS float* lut = (LAS float*)lds;
        for (int i = tid; i < 4096; i += 512) lut[i] = cospif((float)i * (1.0f / 2048.0f));
        __syncthreads();
        const int gt = blockIdx.x * 512 + tid, NT = G * 512;
        bf16_t* DC = (bf16_t*)(ws + WS_DFTC);
        for (int ch = gt; ch < 512 * 32; ch += NT) { const int mrow = ch >> 5, c0 = (ch & 31) * 8, m = mrow & 255, sp = mrow >> 8; float v[8];
#pragma unroll
            for (int j = 0; j < 8; ++j) { const int idx = ((m * (c0 + j)) & 255) * 16; v[j] = sp ? -lut[(idx - 1024) & 4095] * 0.0625f : lut[idx] * 0.0625f; }
            u32x4 o; o.x = cvt_pk_bf16(v[0], v[1]); o.y = cvt_pk_bf16(v[2], v[3]); o.z = cvt_pk_bf16(v[4], v[5]); o.w = cvt_pk_bf16(v[6], v[7]);
            *(u32x4*)(DC + (size_t)mrow * 256 + c0) = o; }
        { float* SS = (float*)(ws + WS_SS); for (int i = gt; i < 6 * MT; i += NT) SS[i] = 0.f; }
        { float* z = (float*)(ws + WS_SSF); for (int i = gt; i < (64 + 16 + 32) * 256; i += NT) z[i] = 0.f; }
        { float* ng = (float*)(ws + WS_NG); for (int i = gt; i < 6 * D; i += NT) ng[i] = p.in[I_NORMG][i]; }
        { float* Hc = (float*)(ws + WS_HC); const f32x4* src = (const f32x4*)p.in[I_CTX];
          for (int i = gt; i < NCTX * D / 4; i += NT) ((f32x4*)Hc)[i] = src[i]; }
    }
    __syncthreads();
}

__device__ __forceinline__ void prenorm_rows(const float* src0, const float* src1, int row_lo, int row_hi, const float* g, const float* scale, float* SS, bf16_t* HB) {
    const int lane = threadIdx.x & 63, wave = threadIdx.x >> 6, gw = blockIdx.x * 8 + wave, NGW = gridDim.x * 8;
    for (int row = row_lo + gw; row < row_hi; row += 2 * NGW) {
        const int rowb = row + NGW; const bool hasb = rowb < row_hi; const int rb = hasb ? rowb : row;
        const float* srca = row < NTOK ? src0 + (size_t)row * D : src1 + (size_t)(row - NTOK) * D;
        const float* srcb = rb < NTOK ? src0 + (size_t)rb * D : src1 + (size_t)(rb - NTOK) * D;
        const int mba = row < NTOK ? (row >> 12) : 4, mbb = rb < NTOK ? (rb >> 12) : 4;
        const f32x4* xa = (const f32x4*)srca + lane; const f32x4* xb = (const f32x4*)srcb + lane;
        f32x4 va[4], vb[4]; float sa = 0.f, sb = 0.f;
#pragma unroll
        for (int j = 0; j < 4; ++j) { va[j] = xa[64 * j]; vb[j] = xb[64 * j]; }
#pragma unroll
        for (int j = 0; j < 4; ++j) { sa += (va[j][0] * va[j][0] + va[j][1] * va[j][1]) + (va[j][2] * va[j][2] + va[j][3] * va[j][3]); sb += (vb[j][0] * vb[j][0] + vb[j][1] * vb[j][1]) + (vb[j][2] * vb[j][2] + vb[j][3] * vb[j][3]); }
        sa = wave_sum(sa); sb = wave_sum(sb);
        if (lane == 0) { SS[row] = sa; if (hasb) SS[rowb] = sb; }
        const f32x4* gp = (const f32x4*)g + lane;
        const f32x4* sca = (const f32x4*)(scale + (size_t)mba * 9216) + lane; const f32x4* scb = (const f32x4*)(scale + (size_t)mbb * 9216) + lane;
        u32x2* oa = (u32x2*)(HB + (size_t)row * D) + lane; u32x2* ob = (u32x2*)(HB + (size_t)rb * D) + lane;
#pragma unroll
        for (int j = 0; j < 4; ++j) { const f32x4 gj = gp[64 * j]; const f32x4 za = va[j] * gj * (sca[64 * j] + 1.0f), zb = vb[j] * gj * (scb[64 * j] + 1.0f);
            u32x2 w; w.x = cvt_pk_bf16(za[0], za[1]); w.y = cvt_pk_bf16(za[2], za[3]); oa[64 * j] = w;
            if (hasb) { w.x = cvt_pk_bf16(zb[0], zb[1]); w.y = cvt_pk_bf16(zb[2], zb[3]); ob[64 * j] = w; } }
    }
}
__device__ __forceinline__ void cb_item(const bf16_t* WT, int ldw, int K, int n0, const float* shift, float* out, int ostride, int lane) {
    const bf16_t* wp = WT + (size_t)(n0 + lane) * ldw;
    float a[5] = {0.f, 0.f, 0.f, 0.f, 0.f};
#pragma unroll 4
    for (int k8 = 0; k8 < K; k8 += 8) {
        const u32x4 q = *(const u32x4*)(wp + k8);
        float w[8];
#pragma unroll
        for (int e = 0; e < 4; ++e) { w[2 * e] = __uint_as_float(q[e] << 16); w[2 * e + 1] = __uint_as_float(q[e] & 0xffff0000u); }
#pragma unroll
        for (int b = 0; b < 5; ++b) { const float* sp = shift + (size_t)b * 9216 + k8;
#pragma unroll
            for (int e = 0; e < 8; ++e) a[b] += w[e] * sp[e]; }
    }
#pragma unroll
    for (int b = 0; b < 5; ++b) out[(size_t)b * ostride + n0 + lane] = a[b];
}
__device__ __forceinline__ void cb_tables(const Params& p) {
    const int lane = threadIdx.x & 63, wave = threadIdx.x >> 6, G = gridDim.x;
    unsigned char* ws = p.ws; const float* MOD = (const float*)(ws + WS_MOD);
    for (int it = blockIdx.x + G * wave; it < 4 * 88 + 40 + 32; it += 8 * G) {
        if (it < 352) { const int mi = it / 88, ch = it % 88, layer = mi >> 1, sub = mi & 1;
            cb_item((const bf16_t*)(ws + WS_W1T + mi * SZ_W1T), D, D, ch * 64, MOD + (size_t)layer * 5 * 9216 + (sub ? 6 : 0) * 1024, (float*)(ws + WS_CB) + (size_t)mi * 5 * NFF1, NFF1, lane); }
        else if (it < 392) { const int ch = it - 352; cb_item((const bf16_t*)(ws + WS_WABT), D, D, ch * 64, MOD + 3 * 1024, (float*)(ws + WS_CBAB), NAB, lane); }
        else { const int e = it - 392, gr = e >> 3, ch = e & 7;
            cb_item((const bf16_t*)(ws + WS_DFTC), 256, 256, ch * 64, MOD + (size_t)5 * 9216 + 3 * 1024 + gr * 256, (float*)(ws + WS_CBD) + gr * 512, 2048, lane); }
    }
}
__device__ __forceinline__ void final_norm_phase(const float* H, const float* g, float* out) {
    const int lane = threadIdx.x & 63, wave = threadIdx.x >> 6, gw = blockIdx.x * 8 + wave, NGW = gridDim.x * 8;
    for (int row = gw; row < NTOK; row += NGW) {
        const f32x4* xr = (const f32x4*)(H + (size_t)row * D) + lane;
        f32x4 v[4]; float s = 0.f;
#pragma unroll
        for (int j = 0; j < 4; ++j) { v[j] = xr[64 * j]; s += (v[j][0] * v[j][0] + v[j][1] * v[j][1]) + (v[j][2] * v[j][2] + v[j][3] * v[j][3]); }
        const float rstd = rsqrtf(wave_sum(s) * (1.0f / D) + 1e-6f);
        const f32x4* gp = (const f32x4*)g + lane; f32x4* o = (f32x4*)(out + (size_t)row * D) + lane;
#pragma unroll
        for (int j = 0; j < 4; ++j) o[64 * j] = v[j] * rstd * gp[64 * j];
    }
}

__device__ __forceinline__ float xrow16_max(float x) {
    auto s_ = __builtin_amdgcn_permlane16_swap(__float_as_uint(x), __float_as_uint(x), false, false);
    x = fmaxf(__uint_as_float(s_[0]), __uint_as_float(s_[1]));
    auto t_ = __builtin_amdgcn_permlane32_swap(__float_as_uint(x), __float_as_uint(x), false, false);
    return fmaxf(__uint_as_float(t_[0]), __uint_as_float(t_[1]));
}
__device__ __forceinline__ float xrow16_sum(float x) {
    auto s_ = __builtin_amdgcn_permlane16_swap(__float_as_uint(x), __float_as_uint(x), false, false);
    x = __uint_as_float(s_[0]) + __uint_as_float(s_[1]);
    auto t_ = __builtin_amdgcn_permlane32_swap(__float_as_uint(x), __float_as_uint(x), false, false);
    return __uint_as_float(t_[0]) + __uint_as_float(t_[1]);
}
struct AttnState { float m, l; f32x4 o[4]; };
__device__ __forceinline__ void attn_group(AttnState& st, const bf16x8 (&kf)[4], const bf16x8 (&vf)[4], const bf16x8 q0, const bf16x8 q1, int cb, int w, const LAS float* rlrow, int g) {
    f32x4 a1 = (f32x4){0.f, 0.f, 0.f, 0.f}, a2 = (f32x4){0.f, 0.f, 0.f, 0.f};
    __builtin_amdgcn_s_setprio(1);
    a1 = __builtin_amdgcn_mfma_f32_16x16x32_bf16(kf[0], q0, a1, 0, 0, 0); a1 = __builtin_amdgcn_mfma_f32_16x16x32_bf16(kf[1], q1, a1, 0, 0, 0);
    a2 = __builtin_amdgcn_mfma_f32_16x16x32_bf16(kf[2], q0, a2, 0, 0, 0); a2 = __builtin_amdgcn_mfma_f32_16x16x32_bf16(kf[3], q1, a2, 0, 0, 0);
    __builtin_amdgcn_s_setprio(0);
    float s[8]; bool ok[8];
#pragma unroll
    for (int e = 0; e < 8; ++e) s[e] = e < 4 ? a1[e] : a2[e - 4];
    if (cb >= 0) {
        const int cs = min(max(w - 8, 0), 48);
#pragma unroll
        for (int e = 0; e < 8; ++e) { const int c = cb + 8 * g + e; ok[e] = (c >= cs) && (c < cs + 16); const int co = c - w + 15; const float bias = rlrow[ok[e] ? co : 0]; s[e] = ok[e] ? s[e] + bias : -1e30f; }
    } else {
#pragma unroll
        for (int e = 0; e < 8; ++e) ok[e] = true;
    }
    float mx = fmaxf(fmaxf(fmaxf(s[0], s[1]), fmaxf(s[2], s[3])), fmaxf(fmaxf(s[4], s[5]), fmaxf(s[6], s[7])));
    mx = xrow16_max(mx);
    const bool keep = __all(mx - st.m <= 8.0f);
    float mnew = st.m;
    if (!keep) { mnew = fmaxf(st.m, mx); const float alpha = fast_exp(st.m - mnew); st.l *= alpha; st.m = mnew;
#pragma unroll
        for (int dt = 0; dt < 4; ++dt) st.o[dt] = st.o[dt] * alpha; }
    float pe[8], ps = 0.f;
#pragma unroll
    for (int e = 0; e < 8; ++e) { pe[e] = ok[e] ? fast_exp(s[e] - mnew) : 0.f; ps += pe[e]; }
    st.l += ps;
    union { u32x4 u; bf16x8 v; } pb;
    pb.u.x = cvt_pk_bf16(pe[0], pe[1]); pb.u.y = cvt_pk_bf16(pe[2], pe[3]); pb.u.z = cvt_pk_bf16(pe[4], pe[5]); pb.u.w = cvt_pk_bf16(pe[6], pe[7]);
#pragma unroll
    for (int dt = 0; dt < 4; ++dt) { if (dt == 0) __builtin_amdgcn_s_setprio(1); st.o[dt] = __builtin_amdgcn_mfma_f32_16x16x32_bf16(vf[dt], pb.v, st.o[dt], 0, 0, 0); }
    __builtin_amdgcn_s_setprio(0);
}

__device__ __forceinline__ void attn_unit(int u, const bf16_t* QB, const bf16_t* KB, const bf16_t* VTL, const bf16_t* VTC, const float* rpb, bf16_t* MIX, LAS float* rl, int lane) {
    const int r = u & 63, h = (u >> 6) & 7, b = u >> 9;
    const int rs = min(max(r - 4, 0), 56);
    const int qi = lane & 15, g = lane >> 4;
    for (int i = lane; i < 465; i += 64) { const int ro = i / 31, co = i - ro * 31; rl[ro * 32 + co] = rpb[h * 465 + i]; }
    asm volatile("s_waitcnt lgkmcnt(0)" ::: "memory");
    AttnState st[4];
    LAS bf16x8* qs = (LAS bf16x8*)(rl + 512) + lane;
#pragma unroll
    for (int qb = 0; qb < 4; ++qb) { st[qb].m = -1e30f; st[qb].l = 0.f;
#pragma unroll
        for (int dt = 0; dt < 4; ++dt) st[qb].o[dt] = (f32x4){0.f, 0.f, 0.f, 0.f};
        const size_t tq = (size_t)b * SEQ + r * 64 + 16 * qb + qi;
        qs[(qb * 2 + 0) * 64] = *(const bf16x8*)(QB + tq * 512 + h * 64 + 8 * g); qs[(qb * 2 + 1) * 64] = *(const bf16x8*)(QB + tq * 512 + h * 64 + 32 + 8 * g); }
    asm volatile("s_waitcnt lgkmcnt(0)" ::: "memory");
    const int kap = 8 * (qi >> 2) + (qi & 3);
    const bf16_t* vtl = VTL + ((size_t)(b * 8 + h) * 64 + qi) * 4096 + 8 * g;
    const bf16_t* vtc = VTC + ((size_t)(b * 8 + h) * 64 + qi) * 256 + 8 * g;
    const bf16_t* kl = KB + ((size_t)b * SEQ + kap) * 512 + h * 64 + 8 * g;
    const bf16_t* kc = KB + ((size_t)NTOK + b * 256 + kap) * 512 + h * 64 + 8 * g;
#define ATT_LOAD(kf, vf, kp, vp, vs) do { kf[0] = *(const bf16x8*)(kp); kf[1] = *(const bf16x8*)((kp) + 32); kf[2] = *(const bf16x8*)((kp) + 4 * 512); kf[3] = *(const bf16x8*)((kp) + 4 * 512 + 32); \
        _Pragma("unroll") for (int dt = 0; dt < 4; ++dt) vf[dt] = *(const bf16x8*)((vp) + (size_t)dt * (vs)); } while (0)
    bf16x8 kA[4], vA[4], kB[4], vB[4];
    ATT_LOAD(kA, vA, kl + (size_t)(rs * 64) * 512, vtl + rs * 64, 16 * 4096);
    for (int a = 0; a < 8; ++a) {
        const int kr = rs + a;
        const LAS float* rlrow = rl + (kr - r + 7) * 32;
        ATT_LOAD(kB, vB, kl + (size_t)(kr * 64 + 32) * 512, vtl + kr * 64 + 32, 16 * 4096);
        __builtin_amdgcn_sched_barrier(0);
#pragma unroll
        for (int qb = 0; qb < 3; ++qb) attn_group(st[qb], kA, vA, qs[(qb * 2 + 0) * 64], qs[(qb * 2 + 1) * 64], 0, 16 * qb + qi, rlrow, g);
        { const bool more = a < 7;
          const bf16_t* kpn = more ? kl + (size_t)((kr + 1) * 64) * 512 : kc; const bf16_t* vpn = more ? vtl + (kr + 1) * 64 : vtc; const int vsn = more ? 16 * 4096 : 16 * 256;
          ATT_LOAD(kA, vA, kpn, vpn, vsn); }
        __builtin_amdgcn_sched_barrier(0);
#pragma unroll
        for (int qb = 1; qb < 4; ++qb) attn_group(st[qb], kB, vB, qs[(qb * 2 + 0) * 64], qs[(qb * 2 + 1) * 64], 32, 16 * qb + qi, rlrow, g);
    }
    for (int cgp = 0; cgp < 8; cgp += 2) {
        ATT_LOAD(kB, vB, kc + (size_t)(32 * (cgp + 1)) * 512, vtc + 32 * (cgp + 1), 16 * 256);
        __builtin_amdgcn_sched_barrier(0);
#pragma unroll
        for (int qb = 0; qb < 4; ++qb) attn_group(st[qb], kA, vA, qs[(qb * 2 + 0) * 64], qs[(qb * 2 + 1) * 64], -1, 0, rl, g);
        if (cgp + 2 < 8) ATT_LOAD(kA, vA, kc + (size_t)(32 * (cgp + 2)) * 512, vtc + 32 * (cgp + 2), 16 * 256);
        __builtin_amdgcn_sched_barrier(0);
#pragma unroll
        for (int qb = 0; qb < 4; ++qb) attn_group(st[qb], kB, vB, qs[(qb * 2 + 0) * 64], qs[(qb * 2 + 1) * 64], -1, 0, rl, g);
    }
#undef ATT_LOAD
#pragma unroll
    for (int qb = 0; qb < 4; ++qb) {
        const float l = xrow16_sum(st[qb].l);
        const float inv = 1.0f / l;
        const size_t tq = (size_t)b * SEQ + r * 64 + 16 * qb + qi;
#pragma unroll
        for (int dt = 0; dt < 4; ++dt) { const f32x4 o = st[qb].o[dt] * inv; u32x2 w; w.x = cvt_pk_bf16(o[0], o[1]); w.y = cvt_pk_bf16(o[2], o[3]);
            PL8(MIX + tq * D + 512 + h * 64 + dt * 16 + 4 * g, w); }
    }
}

__device__ __forceinline__ void conv_phase(const Params& p, const bf16_t* YG, bf16_t* MIX, LAS unsigned char* lds, unsigned* counter) {
    constexpr int TT = 32, NIT = NTOK / TT;
    const int tid = threadIdx.x, lane = tid & 63, wave = tid >> 6, c = tid;
    LAS float* red = (LAS float*)lds;
    LAS float* stat = (LAS float*)(lds + TT * 2048);
    float w[31];
#pragma unroll
    for (int j = 0; j < 31; ++j) w[j] = p.in[I_CONVW][j * 512 + c];
    const float cb = p.in[I_CONVB][c], lg = p.in[I_CONVLNG][c], lb = p.in[I_CONVLNB][c];
    LAS int* qslot = (LAS int*)(lds + TT * 2048 + 1024);
    for (;;) {
        if (tid == 0) *qslot = (int)atomicAdd(counter, 1u);
        __syncthreads();
        const int item = *qslot;
        if (item >= NIT) break;
        const int t0 = item * TT, b = t0 >> 12, n0 = t0 & 4095;
        float in[TT + 30];
#pragma unroll
        for (int i = 0; i < TT + 30; ++i) { const int n = n0 - 15 + i; in[i] = (n >= 0 && n < SEQ) ? bf2f(YG[((size_t)b * SEQ + n) * 512 + c]) : 0.f; }
        float y[TT];
#pragma unroll
        for (int t = 0; t < TT; ++t) { float a = cb;
#pragma unroll
            for (int j = 0; j < 31; ++j) a += in[t + j] * w[j];
            y[t] = a; }
#pragma unroll
        for (int t = 0; t < TT; ++t) red[t * 512 + c] = y[t];
        __syncthreads();
#pragma unroll
        for (int tt = 0; tt < TT / 8; ++tt) { const int t = (TT / 8) * wave + tt; float s = 0.f;
#pragma unroll
            for (int i = 0; i < 8; ++i) s += red[t * 512 + lane + 64 * i];
            s = wave_sum(s); if (lane == 0) stat[t] = s * (1.0f / 512.0f); }
        __syncthreads();
#pragma unroll
        for (int t = 0; t < TT; ++t) { y[t] -= stat[t]; red[t * 512 + c] = y[t] * y[t]; }
        __syncthreads();
#pragma unroll
        for (int tt = 0; tt < TT / 8; ++tt) { const int t = (TT / 8) * wave + tt; float s = 0.f;
#pragma unroll
            for (int i = 0; i < 8; ++i) s += red[t * 512 + lane + 64 * i];
            s = wave_sum(s); if (lane == 0) stat[TT + t] = rsqrtf(s * (1.0f / 512.0f) + 1e-6f); }
        __syncthreads();
#pragma unroll
        for (int t = 0; t < TT; ++t) { const float z = y[t] * stat[TT + t] * lg + lb; const unsigned pk = cvt_pk_bf16(siluf_(z), 0.f);
            PL2(MIX + (size_t)(t0 + t) * D + c, pk & 0xffffu); }
        __syncthreads();
    }
}

__global__ void __launch_bounds__(512, 2) mega(Params p) {
    extern __shared__ __attribute__((aligned(16))) unsigned char lds_raw[];
    LAS unsigned char* lds = (LAS unsigned char*)lds_raw;
    cg::grid_group grid = cg::this_grid();
    const int G = gridDim.x, c = blockIdx.x;
    volatile LAS unsigned* bst = (volatile LAS unsigned*)(lds + 131072 + 64);
    if (threadIdx.x < 2) bst[threadIdx.x] = 0u;
    __syncthreads();
    const XcdBarrier xbar = xcd_barrier_post((unsigned*)(p.ws + WS_BAR), bst);
    if (G > (1 << 20)) grid.sync();
#define GSYNC() xcd_barrier(xbar)
    const int vcu = (G % 8 == 0) ? (c % 8) * (G / 8) + c / 8 : c;
    unsigned char* ws = p.ws;
    float* MOD = (float*)(ws + WS_MOD);
    float* HC = (float*)(ws + WS_HC);
    bf16_t* XN = (bf16_t*)(ws + WS_XN);
    bf16_t* ACT = (bf16_t*)(ws + WS_ACT);
    bf16_t* MIX = (bf16_t*)(ws + WS_MIX); bf16_t* F = (bf16_t*)(ws + WS_F);
    bf16_t *YG = (bf16_t*)(ws + WS_YG), *QB = (bf16_t*)(ws + WS_QB), *KB = (bf16_t*)(ws + WS_KB), *VTL = (bf16_t*)(ws + WS_VTL), *VTC = (bf16_t*)(ws + WS_VTC);
    bf16_t* T = (bf16_t*)(ws + WS_T);

    prologue(p, lds);
    GSYNC();

    float* SS = (float*)(ws + WS_SS);
    const float* NG = p.in[I_NORMG];
    const float* MOD1 = MOD + (size_t)5 * 9216;

    prenorm_rows(p.in[I_X], p.in[I_CTX], 0, MT, NG, MOD + 1 * 1024, SS, XN);
    cb_tables(p);
    GSYNC();

#define FFN_SUBLAYER(inst, nrows, SRC0, SRC1, LASTSUB)                                                                                                 \
    {                                                                                                                                                  \
        constexpr int layer_ = (inst) / 3, sub_ = ((inst) % 3) ? 1 : 0, mi_ = layer_ * 2 + sub_, nx_ = (inst) + 1;                                     \
        const float* mod_l = MOD + (size_t)layer_ * 5 * 9216;                                                                                          \
        { pg8::Gemm g{D, D, D}; PlainOrder S{(const char*)XN, (const char*)(ws + WS_W1T + mi_ * SZ_W1T), (size_t)256 * D * 2, (size_t)256 * D * 2, (nrows) / 256, NFF1 / 256, G, c}; \
          EpiSwiglu E{ws, (inst) * MT, mi_ * 5 * NFF1}; pg8::gemm_phase(lds, g, S, E); }                     \
        GSYNC();                                                                                                                                       \
        { pg8::Gemm g{DFF, DFF, DFF}; PlainOrder S{(const char*)ACT, (const char*)(ws + WS_W2T + mi_ * SZ_W2T), (size_t)256 * DFF * 2, (size_t)256 * DFF * 2, NTOK / 256, D / 256, G, c}; \
          EpiResid<!(LASTSUB), (inst) != 0, false> E{ws, (SRC0), (SRC1), nullptr, 0.5f, layer_ * 5 * 9216 + (sub_ ? 8 : 2) * 1024, nx_ * MT, nx_ * D, (nx_ / 3) * 5 * 9216 + (3 * (nx_ % 3) + 1) * 1024};              \
          pg8::gemm_phase(lds, g, S, E); }                                                                                                             \
        if ((nrows) > NTOK) { pg8::Gemm g{DFF, DFF, 256}; CtxSplitOrder S{(const char*)ACT, (const char*)(ws + WS_W2T), G, c}; EpiCtxAtomic E{HC, mod_l + 4 * 9216 + 2 * 1024, 0.5f}; pg8::gemm_phase(lds, g, S, E); } \
        GSYNC();                                                                                                                                       \
    }

    FFN_SUBLAYER(0, MT, p.in[I_X], p.in[I_CTX] - (size_t)NTOK * D, false);
    prenorm_rows(nullptr, HC, NTOK, MT, NG + 1 * D, MOD + 4 * 1024, SS + (size_t)1 * MT, XN);
    gen_dftl(ws, lds, 128);
    { pg8::Gemm g{D, D, D}; MixInOrder S{(const char*)XN, (const char*)(ws + WS_WABT), G, c, 0, 640}; EpiMixIn E{ws, 1 * MT}; pg8::gemm_phase(lds, g, S, E); }
    GSYNC();
    { pg8::Gemm g{D, D, D}; MixInOrder S{(const char*)XN, (const char*)(ws + WS_WABT), G, c, 640, 656}; EpiMixIn E{ws, 1 * MT}; pg8::gemm_phase(lds, g, S, E); }
    conv_phase(p, YG, MIX, lds, (unsigned*)(ws + WS_BAR) + CNT_WORD);
    GSYNC();
    {
        const int wave = threadIdx.x >> 6, lane = threadIdx.x & 63;
        LAS float* rl = (LAS float*)(lds + 40960 + wave * 10240);
        for (int u = c * 8 + wave; u < 2048; u += G * 8) attn_unit(u, QB, KB, VTL, VTC, p.in[I_RPB], MIX, rl, lane);
    }
    GSYNC();
    { pg8::Gemm g{D, D, D}; PlainOrder S{(const char*)MIX, (const char*)(ws + WS_WOT), (size_t)256 * D * 2, (size_t)256 * D * 2, NTOK / 256, D / 256, G, c};
      EpiResid<true, true, false> E{ws, nullptr, nullptr, nullptr, 1.0f, 5 * 1024, 2 * MT, 2 * D, 7 * 1024}; pg8::gemm_phase(lds, g, S, E); }
    GSYNC();
    FFN_SUBLAYER(2, NTOK, nullptr, nullptr, false);

    FFN_SUBLAYER(3, NTOK, nullptr, nullptr, false);
    { pg8::Gemm g{256, D, 256}; DftAOrder S{(const char*)(ws + WS_DFTC), (const char*)XN, G, vcu}; EpiDftA E{ws, 4 * MT}; pg8::gemm_phase(lds, g, S, E); }
    GSYNC();
    { pg8::Gemm g{8192, 8192, 4096}; DftBOrder S{(const char*)(ws + WS_DFTL), (const char*)T, G, vcu}; EpiDftX E{ws}; pg8::gemm_phase(lds, g, S, E); }
    GSYNC();
    { pg8::Gemm g{D, D, D}; PlainOrder S{(const char*)F, (const char*)(ws + WS_WFT), (size_t)256 * D * 2, (size_t)256 * D * 2, NTOK / 256, D / 256, G, c};
      EpiResid<true, true, true> E{ws, nullptr, nullptr, p.in[I_FNETB], 1.0f, 5 * 9216 + 5 * 1024, 5 * MT, 5 * D, 5 * 9216 + 7 * 1024}; pg8::gemm_phase(lds, g, S, E); }
    GSYNC();
    { pg8::Gemm g{D, D, D}; PlainOrder S{(const char*)XN, (const char*)(ws + WS_W1T + 3 * SZ_W1T), (size_t)256 * D * 2, (size_t)256 * D * 2, NTOK / 256, NFF1 / 256, G, c};
      EpiSwiglu E{ws, 5 * MT, 3 * 5 * NFF1}; pg8::gemm_phase(lds, g, S, E); }
    GSYNC();
    { pg8::Gemm g{DFF, DFF, DFF}; PlainOrder S{(const char*)ACT, (const char*)(ws + WS_W2T + 3 * SZ_W2T), (size_t)256 * DFF * 2, (size_t)256 * DFF * 2, NTOK / 256, D / 256, G, c};
      EpiFinal E{ws, p.out, p.in[I_FINALG], 5 * 9216 + 8 * 1024}; pg8::gemm_phase(lds, g, S, E); }
}

extern "C" void kernel_launch(void* const* d_in, const int* in_sizes, int n_in, void* d_out, int out_size, void* d_ws, size_t ws_size, hipStream_t stream) {
    static int grid = 0;
    if (grid == 0) {
        int dev = 0, cus = 0, per_cu = 0;
        (void)hipGetDevice(&dev);
        (void)hipDeviceGetAttribute(&cus, hipDeviceAttributeMultiprocessorCount, dev);
        (void)hipFuncSetAttribute((const void*)mega, hipFuncAttributeMaxDynamicSharedMemorySize, LDS_BYTES);
        (void)hipOccupancyMaxActiveBlocksPerMultiprocessor(&per_cu, (const void*)mega, 512, LDS_BYTES);
        fprintf(stderr, "kernel_launch: cus %d per_cu %d ws %zu need %zu\n", cus, per_cu, ws_size, (size_t)WS_TOTAL);
        if (n_in != 19 || ws_size < WS_TOTAL || per_cu < 1) { fprintf(stderr, "kernel_launch: unexpected configuration; nothing launched\n"); grid = -1; return; }
        grid = cus;
    }
    if (grid < 0) return;
    Params p{};
    for (int i = 0; i < 19; ++i) p.in[i] = (const float*)d_in[i];
    p.out = (float*)d_out; p.ws = (unsigned char*)d_ws;
    (void)hipMemsetAsync((char*)d_ws + WS_BAR, 0, 16384, stream);
    void* args[] = {&p};
    hipError_t e = hipLaunchCooperativeKernel((const void*)mega, dim3(grid), dim3(512), args, LDS_BYTES, stream);
    if (e != hipSuccess) fprintf(stderr, "cooperative launch failed: %s (grid %d)\n", hipGetErrorString(e), grid);
}
```
